# Optimizing an MI355X kernel written in HIP

```python
import jax
import jax.numpy as jnp
from jax import lax
import numpy as np

D_MODEL = 2048
BATCH = 32
SEQ = 256
DEPTH = 2
DEC_BATCH = 8
DEC_SEQ = 2048
PAST_LEN = 512

GRID_W = 64
N_EVEN = (DEPTH + 1) // 2
N_ODD = DEPTH // 2
HEAD_DIM = 128
A_WIDTH = D_MODEL // 2
B_WIDTH = D_MODEL - A_WIDTH
A_HEADS = A_WIDTH // HEAD_DIM
B_HEADS = B_WIDTH // HEAD_DIM
EVEN_SPLITS = (A_WIDTH,) * 5 + (B_WIDTH,) * 3
EVEN_IN = sum(EVEN_SPLITS)
HGRN_CHUNK = 32
NA_ROWS = 8
NA_COLS = 16
MLA_HEADS = D_MODEL // 128
QK_NOPE = 128
QK_ROPE = 64
V_DIM = 128
Q_RANK = D_MODEL // 4
KV_RANK = D_MODEL // 4
ODD_SPLITS = (Q_RANK, KV_RANK, QK_ROPE)
ODD_IN = sum(ODD_SPLITS)
MLA_SCALE = (QK_NOPE + QK_ROPE) ** -0.5
Q_BLOCK = 128
D_FF = 4 * D_MODEL
ROPE_BASE = 10000.0
EPS = 1e-6
NEG = -1e30
F32 = jnp.float32

kernel_name = 'hybrid_dit_hgrn2_natten_mla_step'


def _rmsnorm(x, g):
    xf = x.astype(F32)
    y = xf * lax.rsqrt(jnp.mean(xf * xf, axis=-1, keepdims=True) + EPS)
    return (y * g.astype(F32)).astype(x.dtype)


def _split(p, sizes):
    out, o = [], 0
    for s in sizes:
        out.append(p[..., o:o + s])
        o += s
    return out


def _heads(a, n):
    return a.reshape(a.shape[0], a.shape[1], n, -1)


def _modulation(cvec, w, b):
    m = jax.nn.silu(cvec) @ w + b
    return m.reshape(m.shape[0], 1, 6, D_MODEL)


def _pre(x, g, mod, k):
    return _rmsnorm(x, g) * (1 + mod[:, :, k + 1]) + mod[:, :, k]


def _post(x, y, g, mod, k):
    return x + mod[:, :, k + 2] * _rmsnorm(y, g)


def _mlp(h, w1, w2):
    a = jax.nn.relu(h @ w1)
    return (a * a) @ w2


def _hgrn_scan(q, k, v, logf, s0):
    B, T, H, _ = q.shape
    n = T // HGRN_CHUNK

    def chunks(a):
        return a.reshape(B, n, HGRN_CHUNK, H, a.shape[-1]).transpose(1, 0, 3, 2, 4)

    tril = jnp.tril(jnp.ones((HGRN_CHUNK, HGRN_CHUNK), bool))[:, :, None]

    def step(S, inp):
        qc, kc, vc, gc = inp
        b = jnp.cumsum(gc, axis=2)
        dec = jnp.where(tril, jnp.exp(jnp.minimum(b[:, :, :, None, :] - b[:, :, None, :, :], 0.0)), 0.0)
        a = jnp.einsum('bhtk,bhsk,bhtsk->bhts', qc, kc, dec)
        o = jnp.einsum('bhtk,bhkv->bhtv', qc * jnp.exp(b), S) + jnp.einsum('bhts,bhsv->bhtv', a, vc)
        b_last = b[:, :, -1, :]
        S_new = jnp.exp(b_last)[..., None] * S + jnp.einsum(
            'bhsk,bhsv->bhkv', kc * jnp.exp(b_last[:, :, None, :] - b), vc)
        return S_new, o

    S, o = lax.scan(step, s0.astype(F32), (chunks(q), chunks(k), chunks(v), chunks(logf)))
    return o.transpose(1, 0, 3, 2, 4).reshape(B, T, H, v.shape[-1]), S


def _hgrn_gate(f_raw, lb):
    f = lb + (1.0 - lb) * jax.nn.sigmoid(f_raw.astype(F32))
    return _heads(1.0 - f, A_HEADS), _heads(jnp.log(f), A_HEADS)


def _hgrn_mixer(q_a, f_fw, f_bw, i_a, g_a, lb_fw, lb_bw, norm_g, s0_fw, s0_bw):
    B, T, _ = q_a.shape
    flip = lambda a: jnp.flip(a, axis=1)
    q = _heads(jax.nn.silu(q_a.astype(F32)) * HEAD_DIM ** -0.5, A_HEADS)
    v = _heads(i_a.astype(F32), A_HEADS)
    k_fw, lf_fw = _hgrn_gate(f_fw, lb_fw)
    k_bw, lf_bw = _hgrn_gate(f_bw, lb_bw)
    o_fw, s_fw = _hgrn_scan(q, k_fw, v, lf_fw, s0_fw)
    o_bw, s_bw = _hgrn_scan(flip(q), flip(k_bw), flip(v), flip(lf_bw), s0_bw)
    o = _rmsnorm(o_fw + flip(o_bw), norm_g) * jax.nn.silu(_heads(g_a.astype(F32), A_HEADS))
    return o.reshape(B, T, A_WIDTH).astype(q_a.dtype), s_fw, s_bw


def _dense_attn(q, k, v):
    s = jnp.einsum('bqhd,bkhd->bhqk', q, k, preferred_element_type=F32) * q.shape[-1] ** -0.5
    p = jax.nn.softmax(s, axis=-1).astype(v.dtype)
    o = jnp.einsum('bhqk,bkhd->bqhd', p, v)
    return o.reshape(o.shape[0], o.shape[1], -1)


def _neighbourhood_attn(q, k, v, k_ctx, v_ctx, rpb):
    B, S, H, Dh = q.shape
    rows = S // GRID_W
    kr = min(NA_ROWS, rows)
    r = jnp.arange(rows)
    row_idx = jnp.clip(r - kr // 2, 0, rows - kr)[:, None] + jnp.arange(kr)[None, :]
    col = jnp.arange(GRID_W)
    cs = jnp.clip(col - NA_COLS // 2, 0, GRID_W - NA_COLS)
    col_ok = (col[None, :] >= cs[:, None]) & (col[None, :] < cs[:, None] + NA_COLS)
    ri = (row_idx - r[:, None] + NA_ROWS - 1)[:, None, :, None]
    ci = jnp.clip(col[None, :] - col[:, None] + NA_COLS - 1, 0, 2 * NA_COLS - 2)[None, :, None, :]
    bias = jnp.where(col_ok[:, None, :], rpb.astype(F32)[:, ri, ci], NEG)
    qg = q.reshape(B, rows, GRID_W, H, Dh)
    k_band = k.reshape(B, rows, GRID_W, H, Dh)[:, row_idx]
    v_band = v.reshape(B, rows, GRID_W, H, Dh)[:, row_idx]
    scale = Dh ** -0.5
    s_lat = jnp.einsum('brqhd,brikhd->bhrqik', qg, k_band, preferred_element_type=F32) * scale + bias[None]
    s_ctx = jnp.einsum('brqhd,blhd->bhrql', qg, k_ctx, preferred_element_type=F32) * scale
    n_lat = kr * GRID_W
    p = jax.nn.softmax(jnp.concatenate([s_lat.reshape(B, H, rows, GRID_W, n_lat), s_ctx], axis=-1),
                       axis=-1).astype(v.dtype)
    o = (jnp.einsum('bhrqik,brikhd->brqhd', p[..., :n_lat].reshape(B, H, rows, GRID_W, kr, GRID_W), v_band)
         + jnp.einsum('bhrql,blhd->brqhd', p[..., n_lat:], v_ctx))
    return o.reshape(B, S, H * Dh)


def _axial_angles(T):
    t = jnp.arange(T)
    half = QK_ROPE // 2
    inv = jnp.power(ROPE_BASE, -jnp.arange(0, half, 2, dtype=F32) / half)
    ang_r = (t // GRID_W).astype(F32)[:, None] * inv
    ang_c = (t % GRID_W).astype(F32)[:, None] * inv
    return ang_r, ang_c


def _rotate(x, ang):
    m = ang.shape[-1]
    cos, sin = jnp.cos(ang)[:, None, :], jnp.sin(ang)[:, None, :]
    x1, x2 = x[..., :m], x[..., m:]
    return jnp.concatenate([x1 * cos - x2 * sin, x2 * cos + x1 * sin], axis=-1)


def _rope2d(x, ang_r, ang_c):
    half = QK_ROPE // 2
    xf = x.astype(F32)
    return jnp.concatenate([_rotate(xf[..., :half], ang_r), _rotate(xf[..., half:], ang_c)],
                           axis=-1).astype(x.dtype)


def _even_context(h, lb_fw, lb_bw, w_in, norm_g, w_out):
    q_a, f_fw, f_bw, i_a, g_a, q_b, k_b, v_b = _split(h @ w_in, EVEN_SPLITS)
    s0 = jnp.zeros((h.shape[0], A_HEADS, HEAD_DIM, HEAD_DIM), F32)
    o_a, s_fw, s_bw = _hgrn_mixer(q_a, f_fw, f_bw, i_a, g_a, lb_fw, lb_bw, norm_g, s0, s0)
    k = _heads(k_b, B_HEADS)
    v = _heads(v_b, B_HEADS)
    o_b = _dense_attn(_heads(q_b, B_HEADS), k, v)
    return jnp.concatenate([o_a, o_b], axis=-1) @ w_out, s_fw, s_bw, k, v


def _even_latent(h, s_fw, s_bw, k_ctx, v_ctx, lb_fw, lb_bw, w_in, norm_g, rpb, w_out):
    q_a, f_fw, f_bw, i_a, g_a, q_b, k_b, v_b = _split(h @ w_in, EVEN_SPLITS)
    o_a, _, _ = _hgrn_mixer(q_a, f_fw, f_bw, i_a, g_a, lb_fw, lb_bw, norm_g, s_fw, s_bw)
    o_b = _neighbourhood_attn(_heads(q_b, B_HEADS), _heads(k_b, B_HEADS), _heads(v_b, B_HEADS),
                              k_ctx, v_ctx, rpb)
    return jnp.concatenate([o_a, o_b], axis=-1) @ w_out


def _mla_project(h, w_in, q_norm_g, w_uq, kv_norm_g):
    cq, ckv, kpe = _split(h @ w_in, ODD_SPLITS)
    q = _heads(_rmsnorm(cq, q_norm_g) @ w_uq, MLA_HEADS)
    return q[..., :QK_NOPE], q[..., QK_NOPE:], _rmsnorm(ckv, kv_norm_g), kpe


def _mla_expand(ckv_n, w_ukv):
    kv = _heads(ckv_n @ w_ukv, MLA_HEADS)
    return kv[..., :QK_NOPE], kv[..., QK_NOPE:]


def _mla_context(h, w_in, q_norm_g, w_uq, kv_norm_g, w_ukv, w_out):
    B, T, _ = h.shape
    q_nope, q_pe, ckv_n, kpe = _mla_project(h, w_in, q_norm_g, w_uq, kv_norm_g)
    k_nope, v = _mla_expand(ckv_n, w_ukv)
    s = (jnp.einsum('bqhd,bkhd->bhqk', q_nope, k_nope, preferred_element_type=F32)
         + jnp.einsum('bqhr,bkr->bhqk', q_pe, kpe, preferred_element_type=F32)) * MLA_SCALE
    p = jax.nn.softmax(s, axis=-1).astype(v.dtype)
    o = jnp.einsum('bhqk,bkhd->bqhd', p, v)
    return o.reshape(B, T, MLA_HEADS * V_DIM) @ w_out, ckv_n, kpe


def _mla_latent(h, ckv_ctx, kpe_ctx, w_in, q_norm_g, w_uq, kv_norm_g, w_ukv, w_out):
    B, T, _ = h.shape
    q_nope, q_pe, ckv_n, kpe = _mla_project(h, w_in, q_norm_g, w_uq, kv_norm_g)
    ang_r, ang_c = _axial_angles(T)
    q_rot = _rope2d(q_pe, ang_r, ang_c)
    k_rot = _rope2d(kpe[:, :, None, :], ang_r, ang_c)[:, :, 0]
    k_nope, v = _mla_expand(ckv_n, w_ukv)
    k_nope_c, v_c = _mla_expand(ckv_ctx, w_ukv)
    nb = T // Q_BLOCK

    def blocks(a):
        return a.reshape(B, nb, Q_BLOCK, *a.shape[2:]).swapaxes(0, 1)

    def attend(blk):
        qn, qr, qp = blk
        s_lat = (jnp.einsum('bqhd,bkhd->bhqk', qn, k_nope, preferred_element_type=F32)
                 + jnp.einsum('bqhr,bkr->bhqk', qr, k_rot, preferred_element_type=F32))
        s_ctx = (jnp.einsum('bqhd,bkhd->bhqk', qn, k_nope_c, preferred_element_type=F32)
                 + jnp.einsum('bqhr,bkr->bhqk', qp, kpe_ctx, preferred_element_type=F32))
        p = jax.nn.softmax(jnp.concatenate([s_lat, s_ctx], axis=-1) * MLA_SCALE, axis=-1).astype(v.dtype)
        return (jnp.einsum('bhqk,bkhd->bqhd', p[..., :T], v)
                + jnp.einsum('bhqk,bkhd->bqhd', p[..., T:], v_c))

    o = lax.map(attend, (blocks(q_nope), blocks(q_rot), blocks(q_pe)))
    return o.swapaxes(0, 1).reshape(B, T, MLA_HEADS * V_DIM) @ w_out


def setup_inputs(seed: int = 0) -> dict:
    key = jax.random.key(seed)
    ks = iter(jax.random.split(key, 32))

    def nrm(shape, scale):
        return jax.random.normal(next(ks), shape, F32) * scale

    def gain(shape):
        return 1.0 + nrm(shape, 0.02)

    return {
        'x_prompt': nrm((BATCH, SEQ, D_MODEL), 1.0),
        'x_sample': nrm((DEC_BATCH, DEC_SEQ, D_MODEL), 1.0),
        'state_hgrn_fwd': nrm((DEC_BATCH, N_EVEN, A_HEADS, HEAD_DIM, HEAD_DIM), 0.5),
        'state_hgrn_bwd': nrm((DEC_BATCH, N_EVEN, A_HEADS, HEAD_DIM, HEAD_DIM), 0.5),
        'cache_na_k': nrm((DEC_BATCH, N_EVEN, PAST_LEN, B_HEADS, HEAD_DIM), 1.0),
        'cache_na_v': nrm((DEC_BATCH, N_EVEN, PAST_LEN, B_HEADS, HEAD_DIM), 1.0),
        'cache_mla_ckv': nrm((DEC_BATCH, N_ODD, PAST_LEN, KV_RANK), 1.0),
        'cache_mla_kpe': nrm((DEC_BATCH, N_ODD, PAST_LEN, QK_ROPE), 1.0),
        'c': nrm((DEC_BATCH, D_MODEL), 1.0),
        'c_ctx': nrm((D_MODEL,), 1.0),
        'ada_w': nrm((DEPTH, D_MODEL, 6 * D_MODEL), 0.5 * D_MODEL ** -0.5),
        'ada_b': nrm((DEPTH, 6 * D_MODEL), 0.02),
        'norm_g': gain((DEPTH, 4, D_MODEL)),
        'hgrn_lb_fwd': nrm((DEPTH + 1, A_WIDTH), 0.5),
        'hgrn_lb_bwd': nrm((DEPTH + 1, A_WIDTH), 0.5),
        'w_in_even': nrm((N_EVEN, D_MODEL, EVEN_IN), D_MODEL ** -0.5),
        'hgrn_norm_g': gain((N_EVEN, HEAD_DIM)),
        'na_rpb': nrm((N_EVEN, B_HEADS, 2 * NA_ROWS - 1, 2 * NA_COLS - 1), 0.1),
        'w_out_even': nrm((N_EVEN, D_MODEL, D_MODEL), D_MODEL ** -0.5),
        'w_in_odd': nrm((N_ODD, D_MODEL, ODD_IN), D_MODEL ** -0.5),
        'mla_q_norm_g': gain((N_ODD, Q_RANK)),
        'w_uq': nrm((N_ODD, Q_RANK, MLA_HEADS * (QK_NOPE + QK_ROPE)), Q_RANK ** -0.5),
        'mla_kv_norm_g': gain((N_ODD, KV_RANK)),
        'w_ukv': nrm((N_ODD, KV_RANK, MLA_HEADS * (QK_NOPE + V_DIM)), KV_RANK ** -0.5),
        'w_out_odd': nrm((N_ODD, MLA_HEADS * V_DIM, D_MODEL), (MLA_HEADS * V_DIM) ** -0.5),
        'mlp_w1': nrm((DEPTH, D_MODEL, D_FF), D_MODEL ** -0.5),
        'mlp_w2': nrm((DEPTH, D_FF, D_MODEL), D_FF ** -0.5),
    }


def reference(x_prompt, x_sample, state_hgrn_fwd, state_hgrn_bwd, cache_na_k, cache_na_v,
              cache_mla_ckv, cache_mla_kpe, c, c_ctx, ada_w, ada_b, norm_g, hgrn_lb_fwd,
              hgrn_lb_bwd, w_in_even, hgrn_norm_g, na_rpb, w_out_even, w_in_odd, mla_q_norm_g,
              w_uq, mla_kv_norm_g, w_ukv, w_out_odd, mlp_w1, mlp_w2):
    lb_fw = jnp.cumsum(jax.nn.softmax(hgrn_lb_fwd.astype(F32), axis=0), axis=0)
    lb_bw = jnp.cumsum(jax.nn.softmax(hgrn_lb_bwd.astype(F32), axis=0), axis=0)
    xc, xs = x_prompt, x_sample
    new_sf, new_sb, new_nk, new_nv, new_ckv, new_kpe = [], [], [], [], [], []
    for l in range(DEPTH):
        j = l // 2
        mod_c = _modulation(c_ctx[None, :], ada_w[l], ada_b[l])
        mod_s = _modulation(c, ada_w[l], ada_b[l])
        hc = _pre(xc, norm_g[l, 0], mod_c, 0)
        hs = _pre(xs, norm_g[l, 0], mod_s, 0)
        if l % 2 == 0:
            yc, sf, sb, nk, nv = _even_context(hc, lb_fw[l], lb_bw[l], w_in_even[j], hgrn_norm_g[j],
                                               w_out_even[j])
            ys = _even_latent(hs, state_hgrn_fwd[:, j], state_hgrn_bwd[:, j], cache_na_k[:, j],
                              cache_na_v[:, j], lb_fw[l], lb_bw[l], w_in_even[j], hgrn_norm_g[j],
                              na_rpb[j], w_out_even[j])
            new_sf.append(sf)
            new_sb.append(sb)
            new_nk.append(nk)
            new_nv.append(nv)
        else:
            yc, ckv, kpe = _mla_context(hc, w_in_odd[j], mla_q_norm_g[j], w_uq[j], mla_kv_norm_g[j],
                                        w_ukv[j], w_out_odd[j])
            ys = _mla_latent(hs, cache_mla_ckv[:, j], cache_mla_kpe[:, j], w_in_odd[j], mla_q_norm_g[j],
                             w_uq[j], mla_kv_norm_g[j], w_ukv[j], w_out_odd[j])
            new_ckv.append(ckv)
            new_kpe.append(kpe)
        xc = _post(xc, yc, norm_g[l, 1], mod_c, 0)
        xs = _post(xs, ys, norm_g[l, 1], mod_s, 0)
        xc = _post(xc, _mlp(_pre(xc, norm_g[l, 2], mod_c, 3), mlp_w1[l], mlp_w2[l]), norm_g[l, 3], mod_c, 3)
        xs = _post(xs, _mlp(_pre(xs, norm_g[l, 2], mod_s, 3), mlp_w1[l], mlp_w2[l]), norm_g[l, 3], mod_s, 3)
    return (xc, xs, jnp.stack(new_sf, axis=1), jnp.stack(new_sb, axis=1), jnp.stack(new_nk, axis=1),
            jnp.stack(new_nv, axis=1), jnp.stack(new_ckv, axis=1), jnp.stack(new_kpe, axis=1))
```

```cpp
#include <hip/hip_runtime.h>
#include <cstdio>
#include <cstdint>
namespace pg8 {
#define PG8_LAS __attribute__((address_space(3)))
typedef unsigned short bf16_t;
typedef short bf16x8 __attribute__((ext_vector_type(8)));
typedef float f32x4 __attribute__((ext_vector_type(4)));
typedef unsigned u32x4 __attribute__((ext_vector_type(4)));
constexpr int BM = 256, BK = 64, HALF = 128, HTB = HALF * BK * 2  , STAGE_BYTES = 8 * HTB, NXCD = 8, WGM = 8;

__host__ __device__ __forceinline__ int lds_byte(int r, int c) { const int st = (r >> 4) * 2 + (c >> 5), rr = r & 15, cc = c & 31, ob = rr * 64 + cc * 2; return st * 1024 + (ob ^ (((ob >> 9) & 1) << 5)); }
__host__ __device__ __forceinline__ void stage_rc(int b, int& R, int& C) { const int st = b / 1024, sb = b % 1024, swz = sb ^ (((sb >> 9) & 1) << 5); R = (st >> 1) * 16 + swz / 64; C = (st & 1) * 32 + (swz % 64) / 2; }
__host__ __device__ __forceinline__ int perm32(int rho) { const int n = rho >> 4, i = rho & 15; return 8 * (i >> 2) + 4 * n + (i & 3); }

struct Unit { int pm, pn; };
struct Gemm { const bf16_t* A; const bf16_t* Bt; int M, N, K; };

struct StaticOrder {
    int nM, nN, nwg, G, c;
    __host__ __device__ void init(int M, int N, int G_, int c_) { nM = M / BM; nN = N / BM; nwg = nM * nN; G = G_; c = c_; }
    __host__ __device__ bool next(int i, Unit& u) const {
        const long L = (long)i * G + c; if (L >= nwg) return false;
        int wgid = (int)L; { const int q = nwg / NXCD, r = nwg % NXCD, xcd = wgid % NXCD, off = wgid / NXCD; wgid = (xcd < r ? xcd * (q + 1) : r * (q + 1) + (xcd - r) * q) + off; }
        const int nig = WGM * nN, gid = wgid / nig, fm = gid * WGM, gsz = (nM - fm) < WGM ? (nM - fm) : WGM;
        u.pm = fm + ((wgid % nig) % gsz); u.pn = (wgid % nig) / gsz; return true;
    }
    __device__ __forceinline__ void a_ready(const Unit&) const {}
    __device__ __forceinline__ void done(const Unit&) const {}
};

__device__ __forceinline__ unsigned cvt_pk_bf16(float lo, float hi) { unsigned r; asm volatile("v_cvt_pk_bf16_f32 %0, %1, %2" : "=v"(r) : "v"(lo), "v"(hi)); return r; }
typedef float f32x2 __attribute__((ext_vector_type(2)));
template <int MODE> struct EpiT {
    static constexpr bool PERM = true, AFTER_DRAIN = false;
    bf16_t* O; int ldc; float* F; int ldf; float* side_k; float* side_v;
    __device__ __forceinline__ void operator()(const f32x4 (&acc)[2][2][4][2], const Unit& u, int wr, int wc, int fr, int fq) const {
        const int row0 = u.pm * BM + wr * 64 + fr; const int col0 = u.pn * BM + wc * 32 + 8 * fq;
#pragma unroll
        for (int ai = 0; ai < 2; ++ai)
#pragma unroll
            for (int m = 0; m < 4; ++m) { const int row = row0 + ai * HALF + m * 16;
#pragma unroll
                for (int bj = 0; bj < 2; ++bj) { f32x4 v0 = acc[ai][bj][m][0], v1 = acc[ai][bj][m][1]; const int col = col0 + bj * HALF;
                    if (MODE == 1) {
#pragma unroll
                        for (int e = 0; e < 4; ++e) { float a = v0[e] > 0.f ? v0[e] : 0.f; v0[e] = a * a; float b = v1[e] > 0.f ? v1[e] : 0.f; v1[e] = b * b; } }
                    if (MODE == 2) { float* fp = F + (size_t)row * ldf + col; *(f32x4*)fp = v0; *(f32x4*)(fp + 4) = v1; }
                    else { u32x4 w; w.x = cvt_pk_bf16(v0[0], v0[1]); w.y = cvt_pk_bf16(v0[2], v0[3]); w.z = cvt_pk_bf16(v1[0], v1[1]); w.w = cvt_pk_bf16(v1[2], v1[3]);
                        *(u32x4*)(O + (size_t)row * ldc + col) = w; }
                    if (MODE == 3) { if (row < 8192 && col >= 6144) { float* fp = (col < 7168) ? side_k + (size_t)row * 1024 + (col - 6144) : side_v + (size_t)row * 1024 + (col - 7168);
                        *(f32x4*)fp = v0; *(f32x4*)(fp + 4) = v1; } }
                } }
    }
};
template <class Epi, class Sched, bool ALIGN_EPI = false, bool SP2 = false>
__device__ __forceinline__ void gemm_phase(PG8_LAS unsigned char* lds, const Gemm g, const Sched& S, const Epi& E) {
    const int tid = threadIdx.x, wid = __builtin_amdgcn_readfirstlane(tid >> 6), lane = tid & 63, wr = wid >> 2, wc = wid & 3, fr = lane & 15, fq = lane >> 4;
    const int K = g.K, nt = K / BK;
    unsigned voffA[2], voffB[2];
#pragma unroll
    for (int i = 0; i < 2; ++i) { int R, C; stage_rc(tid * 16 + i * 8192, R, C); const int Rb = Epi::PERM ? ((R & ~31) + perm32(R & 31)) : R;
        voffA[i] = (unsigned)(R * K + C) * 2u; voffB[i] = (unsigned)(Rb * K + C) * 2u; }
    const size_t kstep = (size_t)(BK * 2);
    const size_t hstep = (size_t)HALF * K * 2;
    const size_t tstep = 2 * hstep;
    const unsigned ldsw = (unsigned)wid * 1024u;
    const int aoff = lds_byte(wr * 64 + fr, fq * 8), boff = lds_byte(wc * 32 + fr, fq * 8);
#define PG8_SA(b, h) (((b) * 2 + (h)) * HTB)
#define PG8_SB(b, h) ((4 + (b) * 2 + (h)) * HTB)
#define PG8_STAGE(bufoff, gbase, voff) do { _Pragma("unroll") for (int _i = 0; _i < 2; ++_i) \
        __builtin_amdgcn_global_load_lds((const unsigned*)((const char*)(gbase) + (voff)[_i]), (PG8_LAS unsigned*)(lds + (bufoff) + ldsw + _i * 8192), 16, 0, 0); } while (0)
#define PG8_LDA(dst, b, h) do { _Pragma("unroll") for (int m = 0; m < 4; ++m) _Pragma("unroll") for (int k = 0; k < 2; ++k) dst[m][k] = *(const PG8_LAS bf16x8*)(lds + PG8_SA(b, h) + aoff + m * 2048 + k * 1024); } while (0)
#define PG8_LDB(dst, b, h) do { _Pragma("unroll") for (int n = 0; n < 2; ++n) _Pragma("unroll") for (int k = 0; k < 2; ++k) dst[n][k] = *(const PG8_LAS bf16x8*)(lds + PG8_SB(b, h) + boff + n * 2048 + k * 1024); } while (0)
#define PG8_MMA(ai, bj, At, Bt) do { __builtin_amdgcn_s_setprio(1); _Pragma("unroll") for (int m = 0; m < 4; ++m) _Pragma("unroll") for (int n = 0; n < 2; ++n) _Pragma("unroll") for (int k = 0; k < 2; ++k) \
        acc[ai][bj][m][n] = __builtin_amdgcn_mfma_f32_16x16x32_bf16(Bt[n][k], At[m][k], acc[ai][bj][m][n], 0, 0, 0); __builtin_amdgcn_s_setprio(0); } while (0)
#define PG8_WAIT_V(n) asm volatile("s_waitcnt vmcnt(" #n ")" ::: "memory")
#define PG8_WAIT_L(n) asm volatile("s_waitcnt lgkmcnt(" #n ")" ::: "memory")
#define PG8_BAR __builtin_amdgcn_s_barrier()
#define PG8_SCHED __builtin_amdgcn_sched_barrier(0)
    Unit cur, nxt; int ui = 0;
    if (!S.next(0, cur)) return;
    f32x4 acc[2][2][4][2];
#pragma unroll
    for (int a = 0; a < 2; ++a)
#pragma unroll
        for (int b = 0; b < 2; ++b)
#pragma unroll
            for (int m = 0; m < 4; ++m)
#pragma unroll
                for (int n = 0; n < 2; ++n) acc[a][b][m][n] = (f32x4){0.f, 0.f, 0.f, 0.f};
    bf16x8 At[4][2], B0[2][2], B1[2][2];
    const char* cA = (const char*)g.A + (size_t)cur.pm * tstep; const char* cB = (const char*)g.Bt + (size_t)cur.pn * tstep;
    S.a_ready(cur);
    if constexpr (SP2) {
        PG8_STAGE(PG8_SB(0, 0), cB, voffB); PG8_STAGE(PG8_SB(0, 1), cB + hstep, voffB); PG8_STAGE(PG8_SA(0, 0), cA, voffA); PG8_STAGE(PG8_SA(0, 1), cA + hstep, voffA);
        if (wr == 1) PG8_BAR;
        PG8_WAIT_V(2); PG8_BAR;
        PG8_STAGE(PG8_SB(1, 0), cB + kstep, voffB); PG8_STAGE(PG8_SA(1, 0), cA + kstep, voffA); PG8_STAGE(PG8_SB(1, 1), cB + hstep + kstep, voffB);
        PG8_WAIT_V(6); PG8_BAR;
    } else {
        PG8_STAGE(PG8_SB(0, 0), cB, voffB); PG8_STAGE(PG8_SA(0, 0), cA, voffA); PG8_STAGE(PG8_SB(0, 1), cB + hstep, voffB); PG8_STAGE(PG8_SA(0, 1), cA + hstep, voffA);
        if (wr == 1) PG8_BAR;
        PG8_WAIT_V(4); PG8_BAR;
        PG8_STAGE(PG8_SB(1, 0), cB + kstep, voffB); PG8_STAGE(PG8_SA(1, 0), cA + kstep, voffA); PG8_STAGE(PG8_SB(1, 1), cB + hstep + kstep, voffB);
        PG8_WAIT_V(6); PG8_BAR;
    }
    for (;;) {
        const bool has_next = S.next(ui + 1, nxt);
        const char* nA = has_next ? (const char*)g.A + (size_t)nxt.pm * tstep : cA; const char* nB = has_next ? (const char*)g.Bt + (size_t)nxt.pn * tstep : cB;
        for (int t = 0; t < nt; t += 2) {
            const bool last = (t == nt - 2);
            const char* a1 = cA + (size_t)(t + 1) * kstep;
            const char* a2 = last ? nA : cA + (size_t)(t + 2) * kstep; const char* b2 = last ? nB : cB + (size_t)(t + 2) * kstep;
            const char* a3 = a2 + kstep; const char* b3 = b2 + kstep;
            if (last && has_next) S.a_ready(nxt);
            if constexpr (SP2) {
            PG8_LDB(B0, 0, 0); PG8_LDB(B1, 0, 1); PG8_SCHED; PG8_LDA(At, 0, 0); PG8_STAGE(PG8_SA(1, 1), a1 + hstep, voffA);
            PG8_WAIT_V(8); PG8_WAIT_L(0); PG8_BAR; PG8_MMA(0, 0, At, B0); PG8_MMA(0, 1, At, B1); PG8_BAR; PG8_SCHED;
            PG8_LDA(At, 0, 1); PG8_STAGE(PG8_SB(0, 0), b2, voffB); PG8_STAGE(PG8_SB(0, 1), b2 + hstep, voffB); PG8_STAGE(PG8_SA(0, 0), a2, voffA);
            PG8_WAIT_V(8); PG8_WAIT_L(0); PG8_BAR; PG8_MMA(1, 0, At, B0); PG8_MMA(1, 1, At, B1); PG8_BAR; PG8_SCHED;
            PG8_LDB(B0, 1, 0); PG8_LDB(B1, 1, 1); PG8_SCHED; PG8_LDA(At, 1, 0); PG8_STAGE(PG8_SA(0, 1), a2 + hstep, voffA);
            PG8_WAIT_V(8); PG8_WAIT_L(0); PG8_BAR; PG8_MMA(0, 0, At, B0); PG8_MMA(0, 1, At, B1); PG8_BAR; PG8_SCHED;
            PG8_LDA(At, 1, 1); PG8_STAGE(PG8_SB(1, 0), b3, voffB); PG8_STAGE(PG8_SB(1, 1), b3 + hstep, voffB); PG8_STAGE(PG8_SA(1, 0), a3, voffA);
            PG8_WAIT_V(8); PG8_WAIT_L(0); PG8_BAR; PG8_MMA(1, 0, At, B0); PG8_MMA(1, 1, At, B1); PG8_BAR; PG8_SCHED;
            } else {
            PG8_LDB(B0, 0, 0); PG8_SCHED; PG8_LDA(At, 0, 0); PG8_STAGE(PG8_SA(1, 1), a1 + hstep, voffA);
            PG8_WAIT_L(8); PG8_BAR; PG8_WAIT_L(0); PG8_MMA(0, 0, At, B0); PG8_BAR; PG8_SCHED;
            PG8_LDB(B1, 0, 1); PG8_STAGE(PG8_SB(0, 0), b2, voffB);
            PG8_BAR; PG8_WAIT_L(0); PG8_MMA(0, 1, At, B1); PG8_BAR;
            PG8_LDA(At, 0, 1); PG8_STAGE(PG8_SA(0, 0), a2, voffA);
            PG8_BAR; PG8_WAIT_L(0); PG8_MMA(1, 0, At, B0); PG8_BAR; PG8_SCHED;
            PG8_STAGE(PG8_SB(0, 1), b2 + hstep, voffB);
            PG8_WAIT_V(6); PG8_BAR; PG8_MMA(1, 1, At, B1); PG8_BAR;
            PG8_LDB(B0, 1, 0); PG8_SCHED; PG8_LDA(At, 1, 0); PG8_STAGE(PG8_SA(0, 1), a2 + hstep, voffA);
            PG8_WAIT_L(8); PG8_BAR; PG8_WAIT_L(0); PG8_MMA(0, 0, At, B0); PG8_BAR; PG8_SCHED;
            PG8_LDB(B1, 1, 1); PG8_STAGE(PG8_SB(1, 0), b3, voffB);
            PG8_BAR; PG8_WAIT_L(0); PG8_MMA(0, 1, At, B1); PG8_BAR;
            PG8_LDA(At, 1, 1); PG8_STAGE(PG8_SA(1, 0), a3, voffA);
            PG8_BAR; PG8_WAIT_L(0); PG8_MMA(1, 0, At, B0); PG8_BAR; PG8_SCHED;
            PG8_STAGE(PG8_SB(1, 1), b3 + hstep, voffB);
            PG8_WAIT_V(6); PG8_BAR; PG8_MMA(1, 1, At, B1); PG8_BAR;
            }
        }
        if constexpr (ALIGN_EPI) { if (wr == 0) PG8_BAR; }
        if constexpr (!Epi::AFTER_DRAIN) { E(acc, cur, wr, wc, fr, fq); S.done(cur); }
        if (!has_next) break;
#pragma unroll
        for (int a = 0; a < 2; ++a)
#pragma unroll
            for (int b = 0; b < 2; ++b)
#pragma unroll
                for (int m = 0; m < 4; ++m)
#pragma unroll
                    for (int n = 0; n < 2; ++n) acc[a][b][m][n] = (f32x4){0.f, 0.f, 0.f, 0.f};
        cur = nxt; cA = nA; cB = nB; ++ui;
        if constexpr (ALIGN_EPI) { if (wr == 1) PG8_BAR; }
    }
    PG8_WAIT_V(0);
    if constexpr (!ALIGN_EPI) { if (wr == 0) PG8_BAR; }
    PG8_BAR;
    if constexpr (Epi::AFTER_DRAIN) { E.fused(acc, cur, wr, wc, fr, fq, lds, wid, lane); S.done(cur); }
#undef PG8_SA
#undef PG8_SB
#undef PG8_STAGE
#undef PG8_LDA
#undef PG8_LDB
#undef PG8_MMA
#undef PG8_WAIT_V
#undef PG8_WAIT_L
#undef PG8_BAR
#undef PG8_SCHED
}
}
constexpr int DM = 2048, DFF = 8192;
constexpr int CB = 32, CT = 256, LBT = 8, LT = 2048, PAST = 512;
constexpr int MC = CB * CT, ML = LBT * LT, MT = MC + ML;
constexpr int MKV = MT + LBT * PAST;
constexpr int EVEN_IN = 8192, ODD_IN = 1088, ODD_PAD = 1280;
constexpr float EPS = 1e-6f;
constexpr float LOG2E = 1.4426950408889634f;
constexpr size_t O_Y = 0, O_SF = (size_t)MT * DM, O_SB = O_SF + 4194304, O_NK = O_SB + 4194304, O_NV = O_NK + 8388608, O_CKV = O_NV + 8388608, O_KPE = O_CKV + 4194304, O_END = O_KPE + 524288;
constexpr size_t MiB = 1u << 20;
constexpr size_t WS_CTL = 0, CTL_ZERO_BYTES = 256 * 1024;
constexpr size_t WS_MOD = 1 * MiB;
constexpr size_t WS_ROPE = 2 * MiB;
constexpr size_t WS_BIAS = 3 * MiB;
constexpr size_t WS_MODP = 5 * MiB;
constexpr size_t WS_WINE = 19 * MiB, WS_WOUTE = 51 * MiB, WS_W1_0 = 59 * MiB, WS_W2_0 = 91 * MiB, WS_W1_1 = 123 * MiB, WS_W2_1 = 155 * MiB;
constexpr size_t WS_WINO = 187 * MiB, WS_WUQ = 192 * MiB, WS_WUKV = 195 * MiB, WS_WOUTO = 199 * MiB;
constexpr size_t WS_B = 207 * MiB;
constexpr size_t WS_C = 303 * MiB;
constexpr size_t WS_CKVX = WS_C + 144 * MiB;
constexpr size_t WS_D = 687 * MiB;
constexpr size_t WS_D_CQN = WS_D, WS_D_CKVN = WS_D + 24 * MiB, WS_D_KROT = WS_D + 52 * MiB;
constexpr size_t WS_D_NAK = WS_D, WS_D_NAV = WS_D + 8 * MiB;
constexpr size_t WS_END = 783 * MiB;
constexpr int CW_BAR = 4096, CW_Q0 = 8192, CW_Q1 = 8192 + 64;
constexpr int RING_BYTES = 131072, LDSCTL_OFF = RING_BYTES, MISC_OFF = LDSCTL_OFF + 320, LDS_BYTES = 147456;

#define GAS __attribute__((address_space(1)))
#define LAS __attribute__((address_space(3)))
typedef unsigned short bf16;
typedef unsigned v4u __attribute__((ext_vector_type(4)));
typedef unsigned v2u __attribute__((ext_vector_type(2)));
typedef float f32x4 __attribute__((ext_vector_type(4)));
typedef float f32x16 __attribute__((ext_vector_type(16)));
typedef short bf16x8 __attribute__((ext_vector_type(8)));
typedef short s16x4 __attribute__((ext_vector_type(4)));
typedef GAS unsigned gu32;
#define RLX_AGENT __ATOMIC_RELAXED, __HIP_MEMORY_SCOPE_AGENT
#define LDS_WAIT() asm volatile("s_waitcnt lgkmcnt(0)" ::: "memory")
#define VM_WAIT() asm volatile("s_waitcnt vmcnt(0)" ::: "memory")
__device__ __forceinline__ unsigned f2bf(float f) { unsigned u = __builtin_bit_cast(unsigned, f); return (u + 0x7fffu + ((u >> 16) & 1u)) >> 16; }
__device__ __forceinline__ unsigned pk2(float lo, float hi) { return f2bf(lo) | (f2bf(hi) << 16); }
__device__ __forceinline__ float bf2f(unsigned short b) { return __builtin_bit_cast(float, (unsigned)b << 16); }
__device__ __forceinline__ float bflo(unsigned w) { return __builtin_bit_cast(float, w << 16); }
__device__ __forceinline__ float bfhi(unsigned w) { return __builtin_bit_cast(float, w & 0xffff0000u); }
__device__ __forceinline__ float wave_sum(float v) {
#pragma unroll
    for (int o = 1; o < 64; o <<= 1) v += __shfl_xor(v, o);
    return v;
}
#define XB_TMO      128
#define XB_XCNT(j)  (256  + 64 * (j))
#define XB_XSUB(j)  (1280 + 64 * (j))
#define XB_XGEN(j)  (2304 + 64 * (j))
#define XB_TOP      3328
#define XB_TOPGEN   3392
#define XCD_BAR_WORDS 3456
#define XB_SPIN_CAP (1u << 18)

__device__ __forceinline__ unsigned xb_ld(unsigned* p)              { return __hip_atomic_load(p, __ATOMIC_RELAXED, __HIP_MEMORY_SCOPE_AGENT); }
__device__ __forceinline__ unsigned xb_add(unsigned* p, unsigned v) { return __hip_atomic_fetch_add(p, v, __ATOMIC_RELAXED, __HIP_MEMORY_SCOPE_AGENT); }
__device__ __forceinline__ unsigned xb_xcc_id() { return (unsigned)__builtin_amdgcn_s_getreg((3 << 11) | 20) & 0xFu; }
#define XB_SPIN(cond, bar) do { unsigned _sp = 0; while (cond) { __builtin_amdgcn_s_sleep(1); \
    if ((++_sp & 255u) == 0u) { if (xb_ld(&(bar)[XB_TMO])) break; if (_sp > XB_SPIN_CAP) { atomicAdd(&(bar)[XB_TMO], 1u); break; } } } } while (0)

struct XcdBarrier {
    unsigned* bar; unsigned x;
    volatile LAS unsigned* st;
};

__device__ __forceinline__ XcdBarrier xcd_barrier_post(unsigned* bar, volatile LAS unsigned* st) {
    XcdBarrier b; b.bar = bar; b.x = xb_xcc_id(); b.st = st;
    if (threadIdx.x == 0) (void)xb_add(&bar[XB_XCNT(b.x)], 1u);
    return b;
}
__device__ __forceinline__ void xcd_barrier_complete(unsigned* bar, unsigned x, unsigned& nloc, unsigned& nx) {
    const unsigned G = gridDim.x * gridDim.y * gridDim.z;
    unsigned sum, cnt, mine, sp = 0u;
    for (;;) {
        sum = 0u; cnt = 0u; mine = 0u;
#pragma unroll
        for (unsigned j = 0; j < 16; ++j) { const unsigned c = xb_ld(&bar[XB_XCNT(j)]); sum += c; cnt += (c > 0u) ? 1u : 0u; mine = (j == x) ? c : mine; }
        if (sum == G) break;
        __builtin_amdgcn_s_sleep(1);
        if ((++sp & 255u) == 0u) { if (xb_ld(&bar[XB_TMO])) break; if (sp > XB_SPIN_CAP) { atomicAdd(&bar[XB_TMO], 1u); break; } }
    }
    nloc = mine > 0u ? mine : 1u; nx = cnt > 0u ? cnt : 1u;
}

__device__ __forceinline__ void xcd_barrier(const XcdBarrier& b) {
    asm volatile("s_waitcnt vmcnt(0)" ::: "memory");
    __syncthreads();
    if (threadIdx.x == 0) {
        unsigned* bar = b.bar;
        __builtin_amdgcn_s_waitcnt(0);
        unsigned nloc = b.st[0], nx = b.st[1];
        if (nloc == 0u) { xcd_barrier_complete(bar, b.x, nloc, nx); b.st[0] = nloc; b.st[1] = nx; }
        const unsigned old = xb_add(&bar[XB_XSUB(b.x)], 1u);
        const unsigned gen = old / nloc;
        if (old + 1u == (gen + 1u) * nloc) {
            __builtin_amdgcn_fence(__ATOMIC_RELEASE, "agent");
            asm volatile("s_waitcnt vmcnt(0)" ::: "memory");
            const unsigned og = xb_add(&bar[XB_TOP], 1u);
            const unsigned tg = og / nx;
            if (og + 1u == (tg + 1u) * nx) xb_add(&bar[XB_TOPGEN], 1u);
            else XB_SPIN(xb_ld(&bar[XB_TOPGEN]) == tg, bar);
            __builtin_amdgcn_fence(__ATOMIC_ACQUIRE, "agent");
            xb_add(&bar[XB_XGEN(b.x)], 1u);
            asm volatile("s_waitcnt vmcnt(0)" ::: "memory");
        } else {
            XB_SPIN(xb_ld(&bar[XB_XGEN(b.x)]) == gen, bar);
            __builtin_amdgcn_fence(__ATOMIC_ACQUIRE, "agent");
            asm volatile("s_waitcnt vmcnt(0)" ::: "memory");
        }
    }
    __syncthreads();
}
struct Args { const float* in[27]; float* out; unsigned char* ws; int ph_lo, ph_hi, li, pad; };
enum { I_XP = 0, I_XS, I_SF, I_SB, I_NAK, I_NAV, I_CKV, I_KPE, I_C, I_CCTX, I_ADAW, I_ADAB, I_NG, I_LBF, I_LBB, I_WINE, I_HNG, I_RPB, I_WOUTE, I_WINO, I_QNG, I_WUQ, I_KVNG, I_WUKV, I_WOUTO, I_W1, I_W2 };

__device__ __forceinline__ void p0_transpose_item(const float* W, int K, int N, bf16* WT, LAS float* scr, int item, int lane) {
    const int nblk = N / 32, kb = item / nblk, nb = item % nblk, k0 = 64 * kb, n0 = 32 * nb;
#pragma unroll 8
    for (int i = 0; i < 32; ++i) { const int kk = 2 * i + (lane >> 5); scr[kk * 33 + (lane & 31)] = W[(size_t)(k0 + kk) * N + n0 + (lane & 31)]; }
    LDS_WAIT(); asm volatile("" ::: "memory");
    const int c = lane & 7;
#pragma unroll
    for (int j = 0; j < 4; ++j) { const int n = (lane >> 3) + 8 * j; const LAS float* s = scr + (8 * c) * 33 + n;
        v4u o; o.x = pk2(s[0 * 33], s[1 * 33]); o.y = pk2(s[2 * 33], s[3 * 33]); o.z = pk2(s[4 * 33], s[5 * 33]); o.w = pk2(s[6 * 33], s[7 * 33]);
        *(GAS v4u*)(WT + (size_t)(n0 + n) * K + k0 + 8 * c) = o; }
    LDS_WAIT(); asm volatile("" ::: "memory");
}

__device__ __forceinline__ void phase_prologue(const Args& a, LAS unsigned char* lds, int tid, int lane, int wave, int vcu, int G) {
    const int gw = vcu * 8 + wave, NGW = G * 8;
    unsigned char* ws = a.ws;
    {
        LAS float* scr = (LAS float*)(lds + wave * 16384);
        constexpr int I_A = 32 * 256, I_B = 32 * 64, I_C1 = 32 * 256, I_C2 = 128 * 64, I_D = 32 * 34, I_E = 8 * 96, I_F = 8 * 128, I_G = 32 * 64;
        constexpr int NITEMS = I_A + I_B + 2 * I_C1 + 2 * I_C2 + I_D + I_E + I_F + I_G;
        for (int it = gw; it < NITEMS; it += NGW) {
            int r = it;
            if (r < I_A) { p0_transpose_item(a.in[I_WINE], 2048, 8192, (bf16*)(ws + WS_WINE), scr, r, lane); continue; } r -= I_A;
            if (r < I_B) { p0_transpose_item(a.in[I_WOUTE], 2048, 2048, (bf16*)(ws + WS_WOUTE), scr, r, lane); continue; } r -= I_B;
            if (r < I_C1) { p0_transpose_item(a.in[I_W1], 2048, 8192, (bf16*)(ws + WS_W1_0), scr, r, lane); continue; } r -= I_C1;
            if (r < I_C1) { p0_transpose_item(a.in[I_W1] + (size_t)2048 * 8192, 2048, 8192, (bf16*)(ws + WS_W1_1), scr, r, lane); continue; } r -= I_C1;
            if (r < I_C2) { p0_transpose_item(a.in[I_W2], 8192, 2048, (bf16*)(ws + WS_W2_0), scr, r, lane); continue; } r -= I_C2;
            if (r < I_C2) { p0_transpose_item(a.in[I_W2] + (size_t)2048 * 8192, 8192, 2048, (bf16*)(ws + WS_W2_1), scr, r, lane); continue; } r -= I_C2;
            if (r < I_D) { p0_transpose_item(a.in[I_WINO], 2048, 1088, (bf16*)(ws + WS_WINO), scr, r, lane); continue; } r -= I_D;
            if (r < I_E) { p0_transpose_item(a.in[I_WUQ], 512, 3072, (bf16*)(ws + WS_WUQ), scr, r, lane); continue; } r -= I_E;
            if (r < I_F) { p0_transpose_item(a.in[I_WUKV], 512, 4096, (bf16*)(ws + WS_WUKV), scr, r, lane); continue; } r -= I_F;
            p0_transpose_item(a.in[I_WOUTO], 2048, 2048, (bf16*)(ws + WS_WOUTO), scr, r, lane);
        }
    }
    const size_t gt = (size_t)gw * 64 + lane, NGT = (size_t)NGW * 64;
    { GAS v4u* z = (GAS v4u*)(ws + WS_WINO + (size_t)1088 * 2048 * 2); for (size_t i = gt; i < (size_t)192 * 2048 * 2 / 16; i += NGT) z[i] = (v4u){0u, 0u, 0u, 0u}; }
    { float* bt = (float*)(ws + WS_BIAS); const float* rpb = a.in[I_RPB];
      for (size_t i = gt; i < (size_t)8 * 15 * 64 * 64; i += NGT) { const int kc = (int)(i & 63), qc = (int)((i >> 6) & 63), hd = (int)(i >> 12);
          int cs = qc - 8; cs = cs < 0 ? 0 : (cs > 48 ? 48 : cs); const bool ok = kc >= cs && kc < cs + 16; int ci = kc - qc + 15; ci = ci < 0 ? 0 : (ci > 30 ? 30 : ci);
          bt[i] = ok ? rpb[hd * 31 + ci] * 11.313708498984761f : -1e30f; } }
    { float* rt = (float*)(ws + WS_ROPE);
      for (size_t i = gt; i < 64 * 32; i += NGT) { const int pos = (int)(i >> 5), j = (int)(i & 31), i16 = j & 15; const float inv = powf(10000.f, -(float)(2 * i16) / 32.f); const float ang = (float)pos * inv;
          rt[i] = j < 16 ? cosf(ang) : sinf(ang); } }
    { const f32x4* sk = (const f32x4*)a.in[I_NAK]; const f32x4* sv = (const f32x4*)a.in[I_NAV]; GAS v2u* dk = (GAS v2u*)(ws + WS_D_NAK); GAS v2u* dv = (GAS v2u*)(ws + WS_D_NAV);
      for (size_t i = gt; i < (size_t)4194304 / 4; i += NGT) { const f32x4 x = sk[i], y = sv[i]; dk[i] = (v2u){pk2(x.x, x.y), pk2(x.z, x.w)}; dv[i] = (v2u){pk2(y.x, y.y), pk2(y.z, y.w)}; } }
    __syncthreads();
    {
        LAS float* S = (LAS float*)lds;
        for (int i = tid; i < 9 * 2048; i += 512) { const int r = i >> 11, k = i & 2047; const float x = r == 0 ? a.in[I_CCTX][k] : a.in[I_C][(r - 1) * 2048 + k]; S[k * 12 + r] = x / (1.f + __expf(-x)); }
        __syncthreads();
        float* modp = (float*)(ws + WS_MODP);
        for (int task = gw; task < 2 * 48 * 16; task += NGW) {
            const int l = task / 768, rem = task % 768, cg = rem >> 4, ks = rem & 15, col = cg * 256 + lane * 4;
            const float* W = a.in[I_ADAW] + ((size_t)l * 2048 + ks * 128) * 12288 + col;
            f32x4 acc[9];
#pragma unroll
            for (int r = 0; r < 9; ++r) acc[r] = (f32x4){0.f, 0.f, 0.f, 0.f};
#pragma unroll 4
            for (int kk = 0; kk < 128; ++kk) { const f32x4 w = *(const f32x4*)(W + (size_t)kk * 12288); const LAS f32x4* sp = (const LAS f32x4*)(S + (ks * 128 + kk) * 12);
                const f32x4 s0 = sp[0], s1 = sp[1], s2 = sp[2];
                acc[0] += w * s0.x; acc[1] += w * s0.y; acc[2] += w * s0.z; acc[3] += w * s0.w; acc[4] += w * s1.x; acc[5] += w * s1.y; acc[6] += w * s1.z; acc[7] += w * s1.w; acc[8] += w * s2.x; }
#pragma unroll
            for (int r = 0; r < 9; ++r) *(f32x4*)(modp + ((size_t)(l * 16 + ks) * 9 + r) * 12288 + col) = acc[r];
        }
    }
}

__device__ __forceinline__ void phase_mod_reduce(const Args& a, int gw, int lane, int NGW) {
    const float* modp = (const float*)(a.ws + WS_MODP); float* mod = (float*)(a.ws + WS_MOD);
    for (size_t i = (size_t)gw * 64 + lane; i < (size_t)2 * 9 * 12288; i += (size_t)NGW * 64) { const int l = (int)(i / 110592), rc = (int)(i % 110592), col = rc % 12288;
        float s = a.in[I_ADAB][l * 12288 + col];
#pragma unroll
        for (int ks = 0; ks < 16; ++ks) s += modp[(size_t)(l * 16 + ks) * 110592 + rc];
        mod[i] = s; }
}

template <bool POST, bool PRE>
__device__ __forceinline__ void row_pass(const float* xc, const float* xs, const bf16* y, float* xdst, bf16* hdst, const float* gpost, const float* gate0, const float* gpre, const float* shift0, const float* scale0,
                                         int gw, int lane, int NGW) {
    for (int m = gw; m < MT; m += NGW) {
        const int grp = m < MC ? 0 : 1 + ((m - MC) >> 11);
        const float* xr = (m < MC) ? xc + (size_t)m * DM : xs + (size_t)(m - MC) * DM;
        f32x4 v[8];
#pragma unroll
        for (int j = 0; j < 8; ++j) v[j] = *(const f32x4*)(xr + 4 * lane + 256 * j);
        if (POST) {
            const bf16* yr = y + (size_t)m * DM; f32x4 t[8]; float ss = 0.f;
#pragma unroll
            for (int j = 0; j < 8; ++j) { const v2u w = *(const v2u*)(yr + 4 * lane + 256 * j); t[j] = (f32x4){bflo(w.x), bfhi(w.x), bflo(w.y), bfhi(w.y)}; ss += (t[j].x * t[j].x + t[j].y * t[j].y) + (t[j].z * t[j].z + t[j].w * t[j].w); }
            const float rs = rsqrtf(wave_sum(ss) * (1.f / DM) + EPS);
            const float* gt = gate0 + (size_t)grp * 12288;
#pragma unroll
            for (int j = 0; j < 8; ++j) { const f32x4 g = *(const f32x4*)(gpost + 4 * lane + 256 * j), ga = *(const f32x4*)(gt + 4 * lane + 256 * j); v[j] = v[j] + ga * (t[j] * rs * g); }
            float* xo = xdst + (size_t)m * DM;
#pragma unroll
            for (int j = 0; j < 8; ++j) *(f32x4*)(xo + 4 * lane + 256 * j) = v[j];
        }
        if (PRE) {
            float ss = 0.f;
#pragma unroll
            for (int j = 0; j < 8; ++j) ss += (v[j].x * v[j].x + v[j].y * v[j].y) + (v[j].z * v[j].z + v[j].w * v[j].w);
            const float rs = rsqrtf(wave_sum(ss) * (1.f / DM) + EPS);
            const float* sh = shift0 + (size_t)grp * 12288; const float* sc = scale0 + (size_t)grp * 12288; bf16* ho = hdst + (size_t)m * DM;
#pragma unroll
            for (int j = 0; j < 8; ++j) { const f32x4 g = *(const f32x4*)(gpre + 4 * lane + 256 * j), s1 = *(const f32x4*)(sc + 4 * lane + 256 * j), s0 = *(const f32x4*)(sh + 4 * lane + 256 * j);
                const f32x4 o = (v[j] * rs * g) * (s1 + 1.f) + s0; *(v2u*)(ho + 4 * lane + 256 * j) = (v2u){pk2(o.x, o.y), pk2(o.z, o.w)}; }
        }
    }
}

__device__ __forceinline__ void phase_hgrn_combine(const Args& a, int gw, int lane, int NGW) {
    const float* ofw = a.out; const float* obw = a.out + (size_t)MT * 1024; const bf16* proj = (const bf16*)(a.ws + WS_C); bf16* ob = (bf16*)(a.ws + WS_B); const float* hng = a.in[I_HNG];
    const int c0 = lane * 16;
    for (int m = gw; m < MT; m += NGW) {
        f32x4 s[4]; float ss = 0.f;
#pragma unroll
        for (int j = 0; j < 4; ++j) { s[j] = *(const f32x4*)(ofw + (size_t)m * 1024 + c0 + 4 * j) + *(const f32x4*)(obw + (size_t)m * 1024 + c0 + 4 * j); ss += (s[j].x * s[j].x + s[j].y * s[j].y) + (s[j].z * s[j].z + s[j].w * s[j].w); }
        ss += __shfl_xor(ss, 1); ss += __shfl_xor(ss, 2); ss += __shfl_xor(ss, 4);
        const float rs = rsqrtf(ss * (1.f / 128.f) + EPS);
        const v4u g0 = *(const v4u*)(proj + (size_t)m * 8192 + 4096 + c0), g1 = *(const v4u*)(proj + (size_t)m * 8192 + 4096 + c0 + 8);
        float gv[16] = {bflo(g0.x), bfhi(g0.x), bflo(g0.y), bfhi(g0.y), bflo(g0.z), bfhi(g0.z), bflo(g0.w), bfhi(g0.w), bflo(g1.x), bfhi(g1.x), bflo(g1.y), bfhi(g1.y), bflo(g1.z), bfhi(g1.z), bflo(g1.w), bfhi(g1.w)};
        float o[16];
#pragma unroll
        for (int j = 0; j < 4; ++j) { const f32x4 gn = *(const f32x4*)(hng + (c0 & 127) + 4 * j);
#pragma unroll
            for (int e = 0; e < 4; ++e) { const float ga = gv[4 * j + e]; o[4 * j + e] = s[j][e] * rs * gn[e] * (ga / (1.f + __expf(-ga))); } }
        v4u w0 = {pk2(o[0], o[1]), pk2(o[2], o[3]), pk2(o[4], o[5]), pk2(o[6], o[7])}, w1 = {pk2(o[8], o[9]), pk2(o[10], o[11]), pk2(o[12], o[13]), pk2(o[14], o[15])};
        *(v4u*)(ob + (size_t)m * 2048 + c0) = w0; *(v4u*)(ob + (size_t)m * 2048 + c0 + 8) = w1;
    }
}

__device__ __forceinline__ void phase_mla_rows(const Args& a, int gw, int lane, int NGW) {
    const float* cqkv = (const float*)(a.ws + WS_C); bf16* cqn = (bf16*)(a.ws + WS_D_CQN); bf16* ckvn = (bf16*)(a.ws + WS_D_CKVN); bf16* krot = (bf16*)(a.ws + WS_D_KROT); const float* rope = (const float*)(a.ws + WS_ROPE);
    const f32x4 gq0 = *(const f32x4*)(a.in[I_QNG] + lane * 8), gq1 = *(const f32x4*)(a.in[I_QNG] + lane * 8 + 4), gk0 = *(const f32x4*)(a.in[I_KVNG] + lane * 8), gk1 = *(const f32x4*)(a.in[I_KVNG] + lane * 8 + 4);
    for (int m = gw; m < MT; m += NGW) {
        const float* r = cqkv + (size_t)m * ODD_PAD;
        { const f32x4 x0 = *(const f32x4*)(r + lane * 8), x1 = *(const f32x4*)(r + lane * 8 + 4);
          const float ss = (x0.x * x0.x + x0.y * x0.y) + (x0.z * x0.z + x0.w * x0.w) + (x1.x * x1.x + x1.y * x1.y) + (x1.z * x1.z + x1.w * x1.w);
          const float rs = rsqrtf(wave_sum(ss) * (1.f / 512.f) + EPS); const f32x4 o0 = x0 * rs * gq0, o1 = x1 * rs * gq1;
          *(v4u*)(cqn + (size_t)m * 512 + lane * 8) = (v4u){pk2(o0.x, o0.y), pk2(o0.z, o0.w), pk2(o1.x, o1.y), pk2(o1.z, o1.w)}; }
        { const f32x4 x0 = *(const f32x4*)(r + 512 + lane * 8), x1 = *(const f32x4*)(r + 512 + lane * 8 + 4);
          const float ss = (x0.x * x0.x + x0.y * x0.y) + (x0.z * x0.z + x0.w * x0.w) + (x1.x * x1.x + x1.y * x1.y) + (x1.z * x1.z + x1.w * x1.w);
          const float rs = rsqrtf(wave_sum(ss) * (1.f / 512.f) + EPS); const f32x4 o0 = x0 * rs * gk0, o1 = x1 * rs * gk1;
          *(v4u*)(ckvn + (size_t)m * 512 + lane * 8) = (v4u){pk2(o0.x, o0.y), pk2(o0.z, o0.w), pk2(o1.x, o1.y), pk2(o1.z, o1.w)};
          if (m < MC) { float* op = a.out + O_CKV + (size_t)m * 512 + lane * 8; *(f32x4*)op = o0; *(f32x4*)(op + 4) = o1; } }
        { const float x = r[1024 + lane];
          if (m < MC) { a.out[O_KPE + (size_t)m * 64 + lane] = x; krot[(size_t)m * 64 + lane] = (bf16)f2bf(x); }
          else { const int pos = (m - MC) & 2047, p = (lane >> 5) ? (pos & 63) : (pos >> 6), j = lane & 31, i16 = j & 15; const float c = rope[p * 32 + i16], s = rope[p * 32 + 16 + i16];
              const float pr = __shfl_xor(x, 16); const float yv = j < 16 ? x * c - pr * s : x * c + pr * s; krot[(size_t)m * 64 + lane] = (bf16)f2bf(yv); } }
    }
    for (int i = gw; i < LBT * PAST; i += NGW) {
        const f32x4 x0 = *(const f32x4*)(a.in[I_CKV] + (size_t)i * 512 + lane * 8), x1 = *(const f32x4*)(a.in[I_CKV] + (size_t)i * 512 + lane * 8 + 4);
        *(v4u*)(ckvn + (size_t)(MT + i) * 512 + lane * 8) = (v4u){pk2(x0.x, x0.y), pk2(x0.z, x0.w), pk2(x1.x, x1.y), pk2(x1.z, x1.w)};
        krot[(size_t)(MT + i) * 64 + lane] = (bf16)f2bf(a.in[I_KPE][(size_t)i * 64 + lane]);
    }
}
__device__ __forceinline__ float swz_xor16(float x) { return __builtin_bit_cast(float, __builtin_amdgcn_ds_swizzle(__builtin_bit_cast(int, x), 0x401F)); }
__device__ __forceinline__ float swz_xor4(float x) { return __builtin_bit_cast(float, __builtin_amdgcn_ds_swizzle(__builtin_bit_cast(int, x), 0x101F)); }
template <int CTRL> __device__ __forceinline__ float dppf(float x) { return __builtin_bit_cast(float, __builtin_amdgcn_update_dpp(0, __builtin_bit_cast(int, x), CTRL, 0xf, 0xf, true)); }
__device__ __forceinline__ float reduce16(const float (&a)[16], int lane) {
    float b[8];
#pragma unroll
    for (int i = 0; i < 8; ++i) { auto r = __builtin_amdgcn_permlane32_swap(__float_as_uint(a[i]), __float_as_uint(a[i + 8]), false, false); b[i] = __uint_as_float(r[0]) + __uint_as_float(r[1]); }
    const bool b4 = (lane & 16) != 0, b3 = (lane & 8) != 0, b2 = (lane & 4) != 0;
    float c[4];
#pragma unroll
    for (int i = 0; i < 4; ++i) { const float send = b4 ? b[i] : b[i + 4], keep = b4 ? b[i + 4] : b[i]; c[i] = keep + swz_xor16(send); }
    float d[2];
#pragma unroll
    for (int i = 0; i < 2; ++i) { const float send = b3 ? c[i] : c[i + 2], keep = b3 ? c[i + 2] : c[i]; d[i] = keep + dppf<0x128>(send); }
    float e; { const float send = b2 ? d[0] : d[1], keep = b2 ? d[1] : d[0]; e = keep + swz_xor4(send); }
    e += dppf<0xB1>(e); e += dppf<0x4E>(e);
    return e;
}

__device__ __forceinline__ void hgrn_item(LAS unsigned char* lds, const Args& a, int type, int b, int h, int dir, int tid) {
    const int wid = __builtin_amdgcn_readfirstlane(tid >> 6), lane = tid & 63;
    const int T = type ? LT : CT, mbase = type ? MC + b * LT : b * CT, NB = T / 32;
    const bf16* proj = (const bf16*)(a.ws + WS_C);
    const int cq = h * 128, cf = (dir ? 2048 : 1024) + h * 128, ci = 3072 + h * 128;
    LAS float* LBv = (LAS float*)(lds + 98304);
    __syncthreads();
    if (tid < 128) { const float* lbp = (dir ? a.in[I_LBB] : a.in[I_LBF]) + h * 128 + tid; const float x0 = lbp[0], x1 = lbp[1024], x2 = lbp[2048]; const float mx = fmaxf(x0, fmaxf(x1, x2));
        const float e0 = __expf(x0 - mx), e1 = __expf(x1 - mx), e2 = __expf(x2 - mx); LBv[tid] = e0 / (e0 + e1 + e2); }
    float S0[16], S1[16];
    if (type) { const float* sp = (dir ? a.in[I_SB] : a.in[I_SF]) + (size_t)(b * 8 + h) * 16384 + 16 * wid;
#pragma unroll
        for (int j = 0; j < 4; ++j) { const f32x4 x = *(const f32x4*)(sp + (size_t)lane * 128 + 4 * j), y = *(const f32x4*)(sp + (size_t)(lane + 64) * 128 + 4 * j);
            S0[4 * j] = x.x; S0[4 * j + 1] = x.y; S0[4 * j + 2] = x.z; S0[4 * j + 3] = x.w; S1[4 * j] = y.x; S1[4 * j + 1] = y.y; S1[4 * j + 2] = y.z; S1[4 * j + 3] = y.w; } }
    else {
#pragma unroll
        for (int i = 0; i < 16; ++i) { S0[i] = 0.f; S1[i] = 0.f; } }
    const int s = tid >> 4, c8 = (tid & 15) * 8;
    v4u gq, gf, gv;
#define HLOAD(n) do { const int p_ = (n) * 32 + s; const int t_ = dir ? T - 1 - p_ : p_; const bf16* rp_ = proj + (size_t)(mbase + t_) * 8192; \
        gq = *(const v4u*)(rp_ + cq + c8); gf = *(const v4u*)(rp_ + cf + c8); gv = *(const v4u*)(rp_ + ci + c8); } while (0)
#define HWRITE(bufi) do { LAS float* F_ = (LAS float*)(lds + (bufi) * 49152) + s * 128 + c8; \
        float fr_[8] = {bflo(gf.x), bfhi(gf.x), bflo(gf.y), bfhi(gf.y), bflo(gf.z), bfhi(gf.z), bflo(gf.w), bfhi(gf.w)}; \
        float qr_[8] = {bflo(gq.x), bfhi(gq.x), bflo(gq.y), bfhi(gq.y), bflo(gq.z), bfhi(gq.z), bflo(gq.w), bfhi(gq.w)}; \
        float fo_[8], qo_[8]; \
        _Pragma("unroll") for (int e_ = 0; e_ < 8; ++e_) { const float lb_ = LBv[c8 + e_]; const float sg_ = 1.f / (1.f + __expf(-fr_[e_])); fo_[e_] = lb_ + (1.f - lb_) * sg_; \
            qo_[e_] = qr_[e_] / (1.f + __expf(-qr_[e_])) * 0.08838834764831845f; } \
        *(LAS f32x4*)F_ = (f32x4){fo_[0], fo_[1], fo_[2], fo_[3]}; *(LAS f32x4*)(F_ + 4) = (f32x4){fo_[4], fo_[5], fo_[6], fo_[7]}; \
        *(LAS f32x4*)(F_ + 4096) = (f32x4){qo_[0], qo_[1], qo_[2], qo_[3]}; *(LAS f32x4*)(F_ + 4100) = (f32x4){qo_[4], qo_[5], qo_[6], qo_[7]}; \
        *(LAS f32x4*)(F_ + 8192) = (f32x4){bflo(gv.x), bfhi(gv.x), bflo(gv.y), bfhi(gv.y)}; *(LAS f32x4*)(F_ + 8196) = (f32x4){bflo(gv.z), bfhi(gv.z), bflo(gv.w), bfhi(gv.w)}; } while (0)
    __syncthreads();
    HLOAD(0); HWRITE(0); __syncthreads();
    float* odir = a.out + (dir ? (size_t)MT * 1024 : 0) + h * 128 + 16 * wid + (((lane >> 5) & 1) << 3 | ((lane >> 4) & 1) << 2 | ((lane >> 3) & 1) << 1 | ((lane >> 2) & 1));
    for (int n = 0; n < NB; ++n) {
        if (n + 1 < NB) HLOAD(n + 1);
        const LAS float* Fb = (const LAS float*)(lds + (n & 1) * 49152);
#pragma unroll 2
        for (int ss = 0; ss < 32; ++ss) {
            const float f0 = Fb[ss * 128 + lane], f1 = Fb[ss * 128 + 64 + lane], q0 = Fb[4096 + ss * 128 + lane], q1 = Fb[4096 + ss * 128 + 64 + lane];
            const float k0 = 1.f - f0, k1 = 1.f - f1;
            float vv[16];
#pragma unroll
            for (int j = 0; j < 4; ++j) { const f32x4 x = *(const LAS f32x4*)(Fb + 8192 + ss * 128 + 16 * wid + 4 * j); vv[4 * j] = x.x; vv[4 * j + 1] = x.y; vv[4 * j + 2] = x.z; vv[4 * j + 3] = x.w; }
            float part[16];
#pragma unroll
            for (int i = 0; i < 16; ++i) { S0[i] = fmaf(k0, vv[i], f0 * S0[i]); S1[i] = fmaf(k1, vv[i], f1 * S1[i]); part[i] = fmaf(q1, S1[i], q0 * S0[i]); }
            const float val = reduce16(part, lane);
            const int p = n * 32 + ss, t = dir ? T - 1 - p : p;
            if ((lane & 3) == 0) odir[(size_t)(mbase + t) * 1024] = val;
        }
        if (n + 1 < NB) HWRITE((n + 1) & 1);
        __syncthreads();
    }
#undef HLOAD
#undef HWRITE
    if (!type) { float* sp = a.out + (dir ? O_SB : O_SF) + (size_t)(b * 8 + h) * 16384 + 16 * wid;
#pragma unroll
        for (int j = 0; j < 4; ++j) { *(f32x4*)(sp + (size_t)lane * 128 + 4 * j) = (f32x4){S0[4 * j], S0[4 * j + 1], S0[4 * j + 2], S0[4 * j + 3]};
            *(f32x4*)(sp + (size_t)(lane + 64) * 128 + 4 * j) = (f32x4){S1[4 * j], S1[4 * j + 1], S1[4 * j + 2], S1[4 * j + 3]}; } }
}

namespace att {
#define KSWZ(row, colB) ((row) * 256 + ((colB) ^ (((row) & 7) << 4)))
#define RSWZ(row, colB) ((row) * 128 + ((colB) ^ (((row) & 7) << 4)))
#define SBAR() __builtin_amdgcn_sched_barrier(0)
constexpr int L_V = 0, L_K = 32768, L_R = 65536, L_WS = 81920;
constexpr float THRL = 11.5f;
__device__ __forceinline__ int crow(int r, int hi) { return (r & 3) + 8 * (r >> 2) + 4 * hi; }
__device__ __forceinline__ unsigned cvtpk(float lo, float hi) { unsigned r; asm volatile("v_cvt_pk_bf16_f32 %0, %1, %2" : "=v"(r) : "v"(lo), "v"(hi)); return r; }
__device__ __forceinline__ int v_st(int k, int c) { const int kk = (k & ~0xC) | ((k & 4) << 1) | ((k & 8) >> 1); return ((kk >> 3) * 4 + (c >> 5)) * 512 + ((kk & 7) * 32 + (c & 31)) * 2; }
__device__ __forceinline__ int v_rd_base(int lane) { return ((lane & 3) << 3) | (((lane >> 2) & 3) << 6) | (((lane >> 4) & 1) << 5) | (((lane >> 5) & 1) << 8); }
constexpr int v_rd_off(int d0, int ks, int half) { return d0 * 512 + ks * 4096 + half * 2048; }
template <int OFF> __device__ __forceinline__ s16x4 tr_read(int vb) { s16x4 r; asm volatile("ds_read_b64_tr_b16 %0, %1 offset:%2" : "=&v"(r) : "v"(vb), "i"(OFF) : "memory"); return r; }
template <int D0> __device__ __forceinline__ void pv_one(f32x16& od, int vb, bf16x8 pa0, bf16x8 pa1, bf16x8 pa2, bf16x8 pa3) {
    const s16x4 l0 = tr_read<v_rd_off(D0, 0, 0)>(vb), h0 = tr_read<v_rd_off(D0, 0, 1)>(vb), l1 = tr_read<v_rd_off(D0, 1, 0)>(vb), h1 = tr_read<v_rd_off(D0, 1, 1)>(vb);
    const s16x4 l2 = tr_read<v_rd_off(D0, 2, 0)>(vb), h2 = tr_read<v_rd_off(D0, 2, 1)>(vb), l3 = tr_read<v_rd_off(D0, 3, 0)>(vb), h3 = tr_read<v_rd_off(D0, 3, 1)>(vb);
    asm volatile("s_waitcnt lgkmcnt(0)" ::: "memory"); SBAR();
#define PK(L, H) (bf16x8){L[0], L[1], L[2], L[3], H[0], H[1], H[2], H[3]}
    od = __builtin_amdgcn_mfma_f32_32x32x16_bf16(pa0, PK(l0, h0), od, 0, 0, 0);
    od = __builtin_amdgcn_mfma_f32_32x32x16_bf16(pa1, PK(l1, h1), od, 0, 0, 0);
    od = __builtin_amdgcn_mfma_f32_32x32x16_bf16(pa2, PK(l2, h2), od, 0, 0, 0);
    od = __builtin_amdgcn_mfma_f32_32x32x16_bf16(pa3, PK(l3, h3), od, 0, 0, 0);
#undef PK
}
struct Seg { const bf16* K; const bf16* V; const bf16* R; int ldk; int nt; };
struct Unit {
    const bf16* Q; int ldq; bf16* O; int ldo; Seg s0, s1;
    const float* rope; int pos0;
    const float* bias; int r0, rs;
    float C;
};
__device__ __forceinline__ bf16x8 ld8(const bf16* p) { return *(const bf16x8*)p; }

template <int DQK, bool NA>
__device__ __forceinline__ void attn_unit(LAS unsigned char* lds, const Unit& U, int tid) {
    const int wid = __builtin_amdgcn_readfirstlane(tid >> 6), lane = tid & 63, r32 = lane & 31, hi = lane >> 5;
    LAS float* wsl = (LAS float*)(lds + L_WS) + wid * 64; LAS float* li_l = wsl; LAS float* al_l = wsl + 32;
    float m_reg = -1e30f, l_reg = 0.f; f32x16 o[4] = {}; bf16x8 qr[DQK / 16];
    const bf16* Qw = U.Q + (size_t)(wid * 32 + r32) * U.ldq + hi * 8;
#pragma unroll
    for (int d0 = 0; d0 < 8; ++d0) qr[d0] = ld8(Qw + d0 * 16);
    if constexpr (DQK == 192) {
        bf16x8 e0 = ld8(Qw + 128), e1 = ld8(Qw + 144), e2 = ld8(Qw + 160), e3 = ld8(Qw + 176);
        if (U.rope) { const int pos = U.pos0 + wid * 32 + r32; const float* tr = U.rope + (pos >> 6) * 32 + hi * 8; const float* tc = U.rope + (pos & 63) * 32 + hi * 8;
            unsigned short a0[8], a1[8], a2[8], a3[8];
#pragma unroll
            for (int j = 0; j < 8; ++j) { float c = tr[j], s = tr[16 + j]; float x1 = bf2f((unsigned short)e0[j]), x2 = bf2f((unsigned short)e1[j]); a0[j] = (unsigned short)f2bf(x1 * c - x2 * s); a1[j] = (unsigned short)f2bf(x2 * c + x1 * s);
                c = tc[j]; s = tc[16 + j]; x1 = bf2f((unsigned short)e2[j]); x2 = bf2f((unsigned short)e3[j]); a2[j] = (unsigned short)f2bf(x1 * c - x2 * s); a3[j] = (unsigned short)f2bf(x2 * c + x1 * s); }
#pragma unroll
            for (int j = 0; j < 8; ++j) { e0[j] = (short)a0[j]; e1[j] = (short)a1[j]; e2[j] = (short)a2[j]; e3[j] = (short)a3[j]; } }
        qr[8] = e0; qr[9] = e1; qr[10] = e2; qr[11] = e3;
    }
    const int sr = tid >> 4, sc = (tid & 15) * 8, vst0 = v_st(sr, sc), vst1 = v_st(32 + sr, sc), rr = tid >> 3, rc = (tid & 7) * 8;
    const int vb0 = (int)(unsigned)(uintptr_t)(lds + L_V) + v_rd_base(lane);
    const int nt0 = U.s0.nt, NT = U.s0.nt + U.s1.nt;
    bf16x8 sv0, sv1, sk0, sk1, srp;
#define SLOAD(j_) do { const bool f_ = (j_) < nt0; const bf16* K_ = f_ ? U.s0.K : U.s1.K; const bf16* V_ = f_ ? U.s0.V : U.s1.V; const int ld_ = f_ ? U.s0.ldk : U.s1.ldk; const int k0_ = (f_ ? (j_) : (j_) - nt0) * 64; \
        const unsigned e0_ = (unsigned)((k0_ + sr) * ld_ + sc), e1_ = e0_ + 32u * (unsigned)ld_; \
        sv0 = ld8(V_ + e0_); sv1 = ld8(V_ + e1_); sk0 = ld8(K_ + e0_); sk1 = ld8(K_ + e1_); \
        if constexpr (DQK == 192) { const bf16* R_ = f_ ? U.s0.R : U.s1.R; srp = ld8(R_ + (unsigned)((k0_ + rr) * 64 + rc)); } } while (0)
#define SWRITE(b_) do { *(LAS bf16x8*)(lds + L_V + (b_) * 16384 + vst0) = sv0; *(LAS bf16x8*)(lds + L_V + (b_) * 16384 + vst1) = sv1; \
        *(LAS bf16x8*)(lds + L_K + (b_) * 16384 + KSWZ(sr, sc * 2)) = sk0; *(LAS bf16x8*)(lds + L_K + (b_) * 16384 + KSWZ(32 + sr, sc * 2)) = sk1; \
        if constexpr (DQK == 192) *(LAS bf16x8*)(lds + L_R + (b_) * 8192 + RSWZ(rr, rc * 2)) = srp; } while (0)
    SLOAD(0); VM_WAIT(); SWRITE(0); __syncthreads();
    const float C = U.C;
    for (int j = 0; j < NT; ++j) {
        const int b = j & 1;
        if (j + 1 < NT) SLOAD(j + 1);
        if constexpr (DQK == 192) { if (j == nt0 && U.rope) { qr[8] = ld8(Qw + 128); qr[9] = ld8(Qw + 144); qr[10] = ld8(Qw + 160); qr[11] = ld8(Qw + 176); } }
        bool valid = true; int dr = 0; const bool lat = NA && j < nt0;
        if (lat) { const int kr = U.rs + j, qrow = U.r0 + (wid >> 1); int w0 = qrow - 4; w0 = w0 < 0 ? 0 : (w0 > 24 ? 24 : w0); valid = kr >= w0 && kr < w0 + 8; dr = kr - qrow + 7; }
        if (valid) {
            f32x16 p0 = {}, p1 = {};
            if (lat) { const float* bp = U.bias + (unsigned)((dr * 64 + 32 * (wid & 1) + r32) * 64 + 4 * hi);
#pragma unroll
                for (int g = 0; g < 4; ++g) { const f32x4 x = *(const f32x4*)(bp + 8 * g), y = *(const f32x4*)(bp + 32 + 8 * g);
                    p0[4 * g] = x.x; p0[4 * g + 1] = x.y; p0[4 * g + 2] = x.z; p0[4 * g + 3] = x.w; p1[4 * g] = y.x; p1[4 * g + 1] = y.y; p1[4 * g + 2] = y.z; p1[4 * g + 3] = y.w; } }
            { const LAS unsigned char* Ks = lds + L_K + b * 16384;
#pragma unroll
              for (int d0 = 0; d0 < 8; ++d0) { const int cb = (d0 * 16 + hi * 8) * 2;
                  const bf16x8 b0 = *(const LAS bf16x8*)(Ks + KSWZ(r32, cb)), b1 = *(const LAS bf16x8*)(Ks + KSWZ(32 + r32, cb));
                  p0 = __builtin_amdgcn_mfma_f32_32x32x16_bf16(b0, qr[d0], p0, 0, 0, 0); p1 = __builtin_amdgcn_mfma_f32_32x32x16_bf16(b1, qr[d0], p1, 0, 0, 0); }
              if constexpr (DQK == 192) { const LAS unsigned char* Rs = lds + L_R + b * 8192;
#pragma unroll
                  for (int d0 = 0; d0 < 4; ++d0) { const int cb = (d0 * 16 + hi * 8) * 2;
                      const bf16x8 b0 = *(const LAS bf16x8*)(Rs + RSWZ(r32, cb)), b1 = *(const LAS bf16x8*)(Rs + RSWZ(32 + r32, cb));
                      p0 = __builtin_amdgcn_mfma_f32_32x32x16_bf16(b0, qr[8 + d0], p0, 0, 0, 0); p1 = __builtin_amdgcn_mfma_f32_32x32x16_bf16(b1, qr[8 + d0], p1, 0, 0, 0); } } }
#pragma unroll
            for (int r = 0; r < 16; ++r) { p0[r] *= C; p1[r] *= C; }
            float pmax = p0[0];
#pragma unroll
            for (int r = 1; r < 16; ++r) pmax = fmaxf(pmax, p0[r]);
#pragma unroll
            for (int r = 0; r < 16; ++r) pmax = fmaxf(pmax, p1[r]);
            { auto x = __builtin_amdgcn_permlane32_swap(__float_as_uint(pmax), __float_as_uint(pmax), false, false); pmax = fmaxf(__uint_as_float(x[0]), __uint_as_float(x[1])); }
            float alpha = 1.f;
            if (!__all(pmax - m_reg <= THRL)) { const float mn = fmaxf(m_reg, pmax); alpha = __builtin_amdgcn_exp2f(m_reg - mn); m_reg = mn; }
            float ps = 0.f;
#pragma unroll
            for (int r = 0; r < 16; ++r) { p0[r] = __builtin_amdgcn_exp2f(p0[r] - m_reg); p1[r] = __builtin_amdgcn_exp2f(p1[r] - m_reg); ps += p0[r] + p1[r]; }
            { auto x = __builtin_amdgcn_permlane32_swap(__float_as_uint(ps), __float_as_uint(ps), false, false); ps = __uint_as_float(x[0]) + __uint_as_float(x[1]); }
            l_reg = l_reg * alpha + ps;
            bf16x8 pa0, pa1, pa2, pa3;
#define PK4(P, BASE, OUT) do { unsigned a0 = cvtpk(P[BASE + 0], P[BASE + 1]), a1 = cvtpk(P[BASE + 2], P[BASE + 3]); unsigned b0 = cvtpk(P[BASE + 4], P[BASE + 5]), b1 = cvtpk(P[BASE + 6], P[BASE + 7]); \
        auto r0 = __builtin_amdgcn_permlane32_swap(a0, b0, false, false); auto r1 = __builtin_amdgcn_permlane32_swap(a1, b1, false, false); \
        v4u w = {r0[0], r1[0], r0[1], r1[1]}; OUT = __builtin_bit_cast(bf16x8, w); } while (0)
            PK4(p0, 0, pa0); PK4(p0, 8, pa1); PK4(p1, 0, pa2); PK4(p1, 8, pa3);
#undef PK4
            if (__any(alpha < 1.f)) { if (hi == 0) al_l[r32] = alpha; LDS_WAIT();
#pragma unroll
                for (int r = 0; r < 16; ++r) { const float av = al_l[crow(r, hi)];
#pragma unroll
                    for (int d = 0; d < 4; ++d) o[d][r] *= av; } }
            const int vb = vb0 + b * 16384;
            pv_one<0>(o[0], vb, pa0, pa1, pa2, pa3); pv_one<1>(o[1], vb, pa0, pa1, pa2, pa3); pv_one<2>(o[2], vb, pa0, pa1, pa2, pa3); pv_one<3>(o[3], vb, pa0, pa1, pa2, pa3);
        }
        if (j + 1 < NT) { VM_WAIT(); SWRITE(b ^ 1); }
        __syncthreads();
    }
#undef SLOAD
#undef SWRITE
    if (hi == 0) li_l[r32] = l_reg;
    LDS_WAIT();
    bf16* Ow = U.O + (size_t)(wid * 32) * U.ldo;
#pragma unroll
    for (int r = 0; r < 16; ++r) { const int orow = crow(r, hi); const float rl = 1.f / li_l[orow];
#pragma unroll
        for (int d0 = 0; d0 < 4; ++d0) Ow[(size_t)orow * U.ldo + d0 * 32 + r32] = (bf16)f2bf(o[d0][r] * rl); }
}
#undef KSWZ
#undef RSWZ
#undef SBAR
}
constexpr int NPHASE = 20;
__device__ __forceinline__ unsigned queue_next(LAS unsigned char* lds, gu32* ctr, int tid) {
    LAS unsigned* qw = (LAS unsigned*)(lds + LDSCTL_OFF + 64);
    __syncthreads();
    if (tid == 0) *qw = __hip_atomic_fetch_add(ctr, 1u, RLX_AGENT);
    __syncthreads();
    return (unsigned)__builtin_amdgcn_readfirstlane((int)*qw);
}

__global__ void __launch_bounds__(512, 2) mega_fwd(Args args) {
    extern __shared__ __attribute__((aligned(16))) unsigned char lds_raw[];
    LAS unsigned char* lds = (LAS unsigned char*)lds_raw;
    const int tid = threadIdx.x, lane = tid & 63, wave = __builtin_amdgcn_readfirstlane(tid >> 6);
    const int G = gridDim.x; const int bx = blockIdx.x; const int vcu = (G % 8 == 0) ? (bx % 8) * (G / 8) + bx / 8 : bx;
    const int gw = vcu * 8 + wave, NGW = G * 8;
    unsigned char* ws = args.ws;
    gu32* ctl = (gu32*)(ws + WS_CTL);
    for (int u = tid; u < (LDS_BYTES - LDSCTL_OFF) / 4; u += 512) ((LAS unsigned*)(lds + LDSCTL_OFF))[u] = 0u;
    __syncthreads();
    volatile LAS unsigned* MISC = (volatile LAS unsigned*)(lds + MISC_OFF);
    XcdBarrier bar = xcd_barrier_post((unsigned*)(ws + WS_CTL) + CW_BAR + args.li * XCD_BAR_WORDS, MISC + 8);
    const int lo = args.ph_lo, hi = args.ph_hi;
#define IN(k) (lo <= (k) && (k) < hi)
#define SEAM(k) do { if (IN(k) && IN((k) + 1)) xcd_barrier(bar); } while (0)
    bf16* Bbuf = (bf16*)(ws + WS_B); bf16* Cbuf = (bf16*)(ws + WS_C); bf16* Dbuf = (bf16*)(ws + WS_D);
    const float* mod = (const float*)(ws + WS_MOD);
    const float* ng = args.in[I_NG];

    if (IN(0)) phase_prologue(args, lds, tid, lane, wave, vcu, G);
    SEAM(0);
    if (IN(1)) phase_mod_reduce(args, gw, lane, NGW);
    SEAM(1);
    if (IN(2)) row_pass<false, true>(args.in[I_XP], args.in[I_XS], nullptr, nullptr, Bbuf, nullptr, nullptr, ng, mod, mod + 2048, gw, lane, NGW);
    SEAM(2);
    if (IN(3)) { pg8::Gemm g{Bbuf, (const bf16*)(ws + WS_WINE), MT, EVEN_IN, DM}; pg8::StaticOrder S; S.init(MT, EVEN_IN, G, bx);
        pg8::EpiT<3> E{Cbuf, EVEN_IN, nullptr, 0, args.out + O_NK, args.out + O_NV};
        pg8::gemm_phase<pg8::EpiT<3>, pg8::StaticOrder, true, true>(lds, g, S, E); }
    SEAM(3);
    if (IN(4)) {
        if (G == 256) { const int n_items = vcu < 128 ? 1 : 4;
            for (int j = 0; j < n_items; ++j) { const int type = vcu < 128 ? 1 : 0; const int i = vcu < 128 ? vcu : (vcu - 128) + 128 * j; hgrn_item(lds, args, type, i >> 4, (i >> 1) & 7, i & 1, tid); } }
        else { for (int it = vcu; it < 640; it += G) { const int type = it < 128 ? 1 : 0; const int i = it < 128 ? it : it - 128; hgrn_item(lds, args, type, i >> 4, (i >> 1) & 7, i & 1, tid); } }
        const bf16* nak = (const bf16*)(ws + WS_D_NAK); const bf16* nav = (const bf16*)(ws + WS_D_NAV); const float* bt = (const float*)(ws + WS_BIAS);
        for (;;) {
            const unsigned u = queue_next(lds, ctl + CW_Q0, tid);
            if (u >= 768u) break;
            att::Unit U; U.ldq = 8192; U.ldo = 2048; U.rope = nullptr; U.pos0 = 0; U.C = 0.08838834764831845f * LOG2E;
            if (u < 512u) { const int b = u >> 6, h = (u >> 3) & 7, qb = u & 7; const size_t row0 = (size_t)MC + b * LT + qb * 256;
                const int r0 = 4 * qb; int rs = r0 - 4; rs = rs < 0 ? 0 : (rs > 24 ? 24 : rs); int re = r0 - 1; re = re < 0 ? 0 : (re > 24 ? 24 : re); re += 8;
                U.Q = Cbuf + row0 * 8192 + 5120 + h * 128; U.O = Bbuf + row0 * 2048 + 1024 + h * 128;
                const bf16* kb = Cbuf + ((size_t)MC + b * LT + rs * 64) * 8192 + 6144 + h * 128;
                U.s0 = att::Seg{kb, kb + 1024, nullptr, 8192, re - rs};
                U.s1 = att::Seg{nak + (size_t)b * 512 * 1024 + h * 128, nav + (size_t)b * 512 * 1024 + h * 128, nullptr, 1024, 8};
                U.bias = bt + (size_t)h * 15 * 4096; U.r0 = r0; U.rs = rs;
                att::attn_unit<128, true>(lds, U, tid); }
            else { const int i = u - 512, b = i >> 3, h = i & 7; const size_t row0 = (size_t)b * CT;
                U.Q = Cbuf + row0 * 8192 + 5120 + h * 128; U.O = Bbuf + row0 * 2048 + 1024 + h * 128;
                const bf16* kb = Cbuf + row0 * 8192 + 6144 + h * 128;
                U.s0 = att::Seg{kb, kb + 1024, nullptr, 8192, 4}; U.s1 = att::Seg{kb, kb + 1024, nullptr, 8192, 0}; U.bias = nullptr; U.r0 = 0; U.rs = 0;
                att::attn_unit<128, false>(lds, U, tid); }
        }
    }
    SEAM(4);
    if (IN(5)) phase_hgrn_combine(args, gw, lane, NGW);
    SEAM(5);
    if (IN(6)) { pg8::Gemm g{Bbuf, (const bf16*)(ws + WS_WOUTE), MT, DM, DM}; pg8::StaticOrder S; S.init(MT, DM, G, bx); pg8::EpiT<0> E{Dbuf, DM, nullptr, 0, nullptr, nullptr};
        pg8::gemm_phase<pg8::EpiT<0>, pg8::StaticOrder, true, true>(lds, g, S, E); }
    SEAM(6);
    if (IN(7)) row_pass<true, true>(args.in[I_XP], args.in[I_XS], Dbuf, args.out, Bbuf, ng + 2048, mod + 2 * 2048, ng + 2 * 2048, mod + 3 * 2048, mod + 4 * 2048, gw, lane, NGW);
    SEAM(7);
    if (IN(8)) { pg8::Gemm g{Bbuf, (const bf16*)(ws + WS_W1_0), MT, DFF, DM}; pg8::StaticOrder S; S.init(MT, DFF, G, bx); pg8::EpiT<1> E{Cbuf, DFF, nullptr, 0, nullptr, nullptr};
        pg8::gemm_phase<pg8::EpiT<1>, pg8::StaticOrder, true, true>(lds, g, S, E); }
    SEAM(8);
    if (IN(9)) { pg8::Gemm g{Cbuf, (const bf16*)(ws + WS_W2_0), MT, DM, DFF}; pg8::StaticOrder S; S.init(MT, DM, G, bx); pg8::EpiT<0> E{Dbuf, DM, nullptr, 0, nullptr, nullptr};
        pg8::gemm_phase<pg8::EpiT<0>, pg8::StaticOrder, true, true>(lds, g, S, E); }
    SEAM(9);
    if (IN(10)) row_pass<true, true>(args.out, args.out + (size_t)MC * DM, Dbuf, args.out, Bbuf, ng + 3 * 2048, mod + 5 * 2048, ng + 4 * 2048, mod + 110592, mod + 110592 + 2048, gw, lane, NGW);
    SEAM(10);
    if (IN(11)) { pg8::Gemm g{Bbuf, (const bf16*)(ws + WS_WINO), MT, ODD_PAD, DM}; pg8::StaticOrder S; S.init(MT, ODD_PAD, G, bx); pg8::EpiT<2> E{nullptr, 0, (float*)(ws + WS_C), ODD_PAD, nullptr, nullptr};
        pg8::gemm_phase<pg8::EpiT<2>, pg8::StaticOrder, true, true>(lds, g, S, E); }
    SEAM(11);
    if (IN(12)) phase_mla_rows(args, gw, lane, NGW);
    SEAM(12);
    if (IN(13)) {
        { pg8::Gemm g{(const bf16*)(ws + WS_D_CQN), (const bf16*)(ws + WS_WUQ), MT, 3072, 512}; pg8::StaticOrder S; S.init(MT, 3072, G, bx); pg8::EpiT<0> E{Cbuf, 3072, nullptr, 0, nullptr, nullptr};
          pg8::gemm_phase<pg8::EpiT<0>, pg8::StaticOrder, true, true>(lds, g, S, E); }
        { pg8::Gemm g{(const bf16*)(ws + WS_D_CKVN), (const bf16*)(ws + WS_WUKV), MKV, 4096, 512}; pg8::StaticOrder S; S.init(MKV, 4096, G, bx); pg8::EpiT<0> E{(bf16*)(ws + WS_CKVX), 4096, nullptr, 0, nullptr, nullptr};
          pg8::gemm_phase<pg8::EpiT<0>, pg8::StaticOrder, true, true>(lds, g, S, E); }
    }
    SEAM(13);
    if (IN(14)) {
        const bf16* qb_ = Cbuf; const bf16* kv = (const bf16*)(ws + WS_CKVX); const bf16* krot = (const bf16*)(ws + WS_D_KROT); const float* rope = (const float*)(ws + WS_ROPE);
        for (;;) {
            const unsigned u = queue_next(lds, ctl + CW_Q1, tid);
            if (u >= 1536u) break;
            att::Unit U; U.ldq = 3072; U.ldo = 2048; U.bias = nullptr; U.r0 = 0; U.rs = 0; U.C = 0.07216878364870322f * LOG2E;
            if (u < 1024u) { const int b = u >> 7, h = (u >> 3) & 15, qb = u & 7; const size_t row0 = (size_t)MC + b * LT + qb * 256;
                U.Q = qb_ + row0 * 3072 + h * 192; U.O = Bbuf + row0 * 2048 + h * 128; U.rope = rope; U.pos0 = qb * 256;
                const bf16* kb = kv + ((size_t)MC + b * LT) * 4096 + h * 256; const bf16* kc = kv + ((size_t)MT + b * PAST) * 4096 + h * 256;
                U.s0 = att::Seg{kb, kb + 128, krot + ((size_t)MC + b * LT) * 64, 4096, 32}; U.s1 = att::Seg{kc, kc + 128, krot + ((size_t)MT + b * PAST) * 64, 4096, 8}; }
            else { const int i = u - 1024, b = i >> 4, h = i & 15; const size_t row0 = (size_t)b * CT;
                U.Q = qb_ + row0 * 3072 + h * 192; U.O = Bbuf + row0 * 2048 + h * 128; U.rope = nullptr; U.pos0 = 0;
                const bf16* kb = kv + row0 * 4096 + h * 256;
                U.s0 = att::Seg{kb, kb + 128, krot + row0 * 64, 4096, 4}; U.s1 = att::Seg{kb, kb + 128, krot + row0 * 64, 4096, 0}; }
            att::attn_unit<192, false>(lds, U, tid);
        }
    }
    SEAM(14);
    if (IN(15)) { pg8::Gemm g{Bbuf, (const bf16*)(ws + WS_WOUTO), MT, DM, DM}; pg8::StaticOrder S; S.init(MT, DM, G, bx); pg8::EpiT<0> E{Dbuf, DM, nullptr, 0, nullptr, nullptr};
        pg8::gemm_phase<pg8::EpiT<0>, pg8::StaticOrder, true, true>(lds, g, S, E); }
    SEAM(15);
    { const float* mod1 = mod + 110592; const float* ng1 = ng + 4 * 2048;
    if (IN(16)) row_pass<true, true>(args.out, args.out + (size_t)MC * DM, Dbuf, args.out, Bbuf, ng1 + 2048, mod1 + 2 * 2048, ng1 + 2 * 2048, mod1 + 3 * 2048, mod1 + 4 * 2048, gw, lane, NGW);
    SEAM(16);
    if (IN(17)) { pg8::Gemm g{Bbuf, (const bf16*)(ws + WS_W1_1), MT, DFF, DM}; pg8::StaticOrder S; S.init(MT, DFF, G, bx); pg8::EpiT<1> E{Cbuf, DFF, nullptr, 0, nullptr, nullptr};
        pg8::gemm_phase<pg8::EpiT<1>, pg8::StaticOrder, true, true>(lds, g, S, E); }
    SEAM(17);
    if (IN(18)) { pg8::Gemm g{Cbuf, (const bf16*)(ws + WS_W2_1), MT, DM, DFF}; pg8::StaticOrder S; S.init(MT, DM, G, bx); pg8::EpiT<0> E{Dbuf, DM, nullptr, 0, nullptr, nullptr};
        pg8::gemm_phase<pg8::EpiT<0>, pg8::StaticOrder, true, true>(lds, g, S, E); }
    SEAM(18);
    if (IN(19)) row_pass<true, false>(args.out, args.out + (size_t)MC * DM, Dbuf, args.out, nullptr, ng1 + 3 * 2048, mod1 + 5 * 2048, nullptr, nullptr, nullptr, gw, lane, NGW);
    }
#undef IN
#undef SEAM
}

#ifndef MK_SPLITS
#define MK_SPLITS 1
#endif
extern "C" void kernel_launch(void* const* d_in, const int* in_sizes, int n_in, void* d_out, int out_size, void* d_ws, size_t ws_size, hipStream_t stream) {
    static int grid = 0;
    if (grid == 0) {
        if (n_in != 27 || (size_t)out_size != O_END || ws_size < WS_END) { fprintf(stderr, "kernel_launch: shape mismatch n_in %d out %d ws %zu (need %zu)\n", n_in, out_size, ws_size, (size_t)WS_END); grid = -1; return; }
        int dev = 0, cus = 0, per_cu = 0;
        if (hipGetDevice(&dev) != hipSuccess || hipDeviceGetAttribute(&cus, hipDeviceAttributeMultiprocessorCount, dev) != hipSuccess) { grid = -1; return; }
        if (hipFuncSetAttribute((const void*)mega_fwd, hipFuncAttributeMaxDynamicSharedMemorySize, LDS_BYTES) != hipSuccess) { fprintf(stderr, "kernel_launch: hipFuncSetAttribute failed\n"); grid = -1; return; }
        if (hipOccupancyMaxActiveBlocksPerMultiprocessor(&per_cu, (const void*)mega_fwd, 512, LDS_BYTES) != hipSuccess || per_cu < 1) { fprintf(stderr, "kernel_launch: occupancy query says %d\n", per_cu); }
        (void)hipGetLastError();
        grid = cus;
    }
    if (grid < 0) return;
    (void)hipMemsetAsync((char*)d_ws + WS_CTL, 0, CTL_ZERO_BYTES, stream);
    Args a{};
    for (int i = 0; i < 27; ++i) a.in[i] = (const float*)d_in[i];
    a.out = (float*)d_out; a.ws = (unsigned char*)d_ws; a.pad = 0;
#if MK_SPLITS == 1
    a.ph_lo = 0; a.ph_hi = NPHASE; a.li = 0;
    hipLaunchKernelGGL(mega_fwd, dim3(grid), dim3(512), LDS_BYTES, stream, a);
#else
    for (int k = 0; k < NPHASE; ++k) { a.ph_lo = k; a.ph_hi = k + 1; a.li = 0; hipLaunchKernelGGL(mega_fwd, dim3(grid), dim3(512), LDS_BYTES, stream, a); }
#endif
}
```

```cpp
#include <hip/hip_runtime.h>
#include <cstdio>
#include <cstdint>
namespace pg8 {
#define PG8_LAS __attribute__((address_space(3)))
typedef unsigned short bf16_t;
typedef short bf16x8 __attribute__((ext_vector_type(8)));
typedef float f32x4 __attribute__((ext_vector_type(4)));
typedef unsigned u32x4 __attribute__((ext_vector_type(4)));
constexpr int BM = 256, BK = 64, HALF = 128, HTB = HALF * BK * 2  , STAGE_BYTES = 8 * HTB, NXCD = 8, WGM = 8;

__host__ __device__ __forceinline__ int lds_byte(int r, int c) { const int st = (r >> 4) * 2 + (c >> 5), rr = r & 15, cc = c & 31, ob = rr * 64 + cc * 2; return st * 1024 + (ob ^ (((ob >> 9) & 1) << 5)); }
__host__ __device__ __forceinline__ void stage_rc(int b, int& R, int& C) { const int st = b / 1024, sb = b % 1024, swz = sb ^ (((sb >> 9) & 1) << 5); R = (st >> 1) * 16 + swz / 64; C = (st & 1) * 32 + (swz % 64) / 2; }
__host__ __device__ __forceinline__ int perm32(int rho) { const int n = rho >> 4, i = rho & 15; return 8 * (i >> 2) + 4 * n + (i & 3); }

struct Unit { int pm, pn; };
struct Gemm { const bf16_t* A; const bf16_t* Bt; int M, N, K; };

struct StaticOrder {
    int nM, nN, nwg, G, c;
    __host__ __device__ void init(int M, int N, int G_, int c_) { nM = M / BM; nN = N / BM; nwg = nM * nN; G = G_; c = c_; }
    __host__ __device__ bool next(int i, Unit& u) const {
        const long L = (long)i * G + c; if (L >= nwg) return false;
        int wgid = (int)L; { const int q = nwg / NXCD, r = nwg % NXCD, xcd = wgid % NXCD, off = wgid / NXCD; wgid = (xcd < r ? xcd * (q + 1) : r * (q + 1) + (xcd - r) * q) + off; }
        const int nig = WGM * nN, gid = wgid / nig, fm = gid * WGM, gsz = (nM - fm) < WGM ? (nM - fm) : WGM;
        u.pm = fm + ((wgid % nig) % gsz); u.pn = (wgid % nig) / gsz; return true;
    }
    __device__ __forceinline__ void a_ready(const Unit&) const {}
    __device__ __forceinline__ void done(const Unit&) const {}
};

__device__ __forceinline__ unsigned cvt_pk_bf16(float lo, float hi) { unsigned r; asm volatile("v_cvt_pk_bf16_f32 %0, %1, %2" : "=v"(r) : "v"(lo), "v"(hi)); return r; }
typedef float f32x2 __attribute__((ext_vector_type(2)));
template <int MODE> struct EpiT {
    static constexpr bool PERM = true, AFTER_DRAIN = false;
    bf16_t* O; int ldc; float* F; int ldf; float* side_k; float* side_v;
    __device__ __forceinline__ void operator()(const f32x4 (&acc)[2][2][4][2], const Unit& u, int wr, int wc, int fr, int fq) const {
        const int row0 = u.pm * BM + wr * 64 + fr; const int col0 = u.pn * BM + wc * 32 + 8 * fq;
#pragma unroll
        for (int ai = 0; ai < 2; ++ai)
#pragma unroll
            for (int m = 0; m < 4; ++m) { const int row = row0 + ai * HALF + m * 16;
#pragma unroll
                for (int bj = 0; bj < 2; ++bj) { f32x4 v0 = acc[ai][bj][m][0], v1 = acc[ai][bj][m][1]; const int col = col0 + bj * HALF;
                    if (MODE == 1) {
#pragma unroll
                        for (int e = 0; e < 4; ++e) { float a = v0[e] > 0.f ? v0[e] : 0.f; v0[e] = a * a; float b = v1[e] > 0.f ? v1[e] : 0.f; v1[e] = b * b; } }
                    if (MODE == 2) { float* fp = F + (size_t)row * ldf + col; *(f32x4*)fp = v0; *(f32x4*)(fp + 4) = v1; }
                    else { u32x4 w; w.x = cvt_pk_bf16(v0[0], v0[1]); w.y = cvt_pk_bf16(v0[2], v0[3]); w.z = cvt_pk_bf16(v1[0], v1[1]); w.w = cvt_pk_bf16(v1[2], v1[3]);
                        *(u32x4*)(O + (size_t)row * ldc + col) = w; }
                    if (MODE == 3) { if (row < 8192 && col >= 6144) { float* fp = (col < 7168) ? side_k + (size_t)row * 1024 + (col - 6144) : side_v + (size_t)row * 1024 + (col - 7168);
                        *(f32x4*)fp = v0; *(f32x4*)(fp + 4) = v1; } }
                } }
    }
};
template <class Epi, class Sched, bool ALIGN_EPI = false, bool SP2 = false>
__device__ __forceinline__ void gemm_phase(PG8_LAS unsigned char* lds, const Gemm g, const Sched& S, const Epi& E) {
    const int tid = threadIdx.x, wid = __builtin_amdgcn_readfirstlane(tid >> 6), lane = tid & 63, wr = wid >> 2, wc = wid & 3, fr = lane & 15, fq = lane >> 4;
    const int K = g.K, nt = K / BK;
    unsigned voffA[2], voffB[2];
#pragma unroll
    for (int i = 0; i < 2; ++i) { int R, C; stage_rc(tid * 16 + i * 8192, R, C); const int Rb = Epi::PERM ? ((R & ~31) + perm32(R & 31)) : R;
        voffA[i] = (unsigned)(R * K + C) * 2u; voffB[i] = (unsigned)(Rb * K + C) * 2u; }
    const size_t kstep = (size_t)(BK * 2);
    const size_t hstep = (size_t)HALF * K * 2;
    const size_t tstep = 2 * hstep;
    const unsigned ldsw = (unsigned)wid * 1024u;
    const int aoff = lds_byte(wr * 64 + fr, fq * 8), boff = lds_byte(wc * 32 + fr, fq * 8);
#define PG8_SA(b, h) (((b) * 2 + (h)) * HTB)
#define PG8_SB(b, h) ((4 + (b) * 2 + (h)) * HTB)
#define PG8_STAGE(bufoff, gbase, voff) do { _Pragma("unroll") for (int _i = 0; _i < 2; ++_i) \
        __builtin_amdgcn_global_load_lds((const unsigned*)((const char*)(gbase) + (voff)[_i]), (PG8_LAS unsigned*)(lds + (bufoff) + ldsw + _i * 8192), 16, 0, 0); } while (0)
#define PG8_LDA(dst, b, h) do { _Pragma("unroll") for (int m = 0; m < 4; ++m) _Pragma("unroll") for (int k = 0; k < 2; ++k) dst[m][k] = *(const PG8_LAS bf16x8*)(lds + PG8_SA(b, h) + aoff + m * 2048 + k * 1024); } while (0)
#define PG8_LDB(dst, b, h) do { _Pragma("unroll") for (int n = 0; n < 2; ++n) _Pragma("unroll") for (int k = 0; k < 2; ++k) dst[n][k] = *(const PG8_LAS bf16x8*)(lds + PG8_SB(b, h) + boff + n * 2048 + k * 1024); } while (0)
#define PG8_MMA(ai, bj, At, Bt) do { __builtin_amdgcn_s_setprio(1); _Pragma("unroll") for (int m = 0; m < 4; ++m) _Pragma("unroll") for (int n = 0; n < 2; ++n) _Pragma("unroll") for (int k = 0; k < 2; ++k) \
        acc[ai][bj][m][n] = __builtin_amdgcn_mfma_f32_16x16x32_bf16(Bt[n][k], At[m][k], acc[ai][bj][m][n], 0, 0, 0); __builtin_amdgcn_s_setprio(0); } while (0)
#define PG8_WAIT_V(n) asm volatile("s_waitcnt vmcnt(" #n ")" ::: "memory")
#define PG8_WAIT_L(n) asm volatile("s_waitcnt lgkmcnt(" #n ")" ::: "memory")
#define PG8_BAR __builtin_amdgcn_s_barrier()
#define PG8_SCHED __builtin_amdgcn_sched_barrier(0)
    Unit cur, nxt; int ui = 0;
    if (!S.next(0, cur)) return;
    f32x4 acc[2][2][4][2];
#pragma unroll
    for (int a = 0; a < 2; ++a)
#pragma unroll
        for (int b = 0; b < 2; ++b)
#pragma unroll
            for (int m = 0; m < 4; ++m)
#pragma unroll
                for (int n = 0; n < 2; ++n) acc[a][b][m][n] = (f32x4){0.f, 0.f, 0.f, 0.f};
    bf16x8 At[4][2], B0[2][2], B1[2][2];
    const char* cA = (const char*)g.A + (size_t)cur.pm * tstep; const char* cB = (const char*)g.Bt + (size_t)cur.pn * tstep;
    S.a_ready(cur);
    if constexpr (SP2) {
        PG8_STAGE(PG8_SB(0, 0), cB, voffB); PG8_STAGE(PG8_SB(0, 1), cB + hstep, voffB); PG8_STAGE(PG8_SA(0, 0), cA, voffA); PG8_STAGE(PG8_SA(0, 1), cA + hstep, voffA);
        if (wr == 1) PG8_BAR;
        PG8_WAIT_V(2); PG8_BAR;
        PG8_STAGE(PG8_SB(1, 0), cB + kstep, voffB); PG8_STAGE(PG8_SA(1, 0), cA + kstep, voffA); PG8_STAGE(PG8_SB(1, 1), cB + hstep + kstep, voffB);
        PG8_WAIT_V(6); PG8_BAR;
    } else {
        PG8_STAGE(PG8_SB(0, 0), cB, voffB); PG8_STAGE(PG8_SA(0, 0), cA, voffA); PG8_STAGE(PG8_SB(0, 1), cB + hstep, voffB); PG8_STAGE(PG8_SA(0, 1), cA + hstep, voffA);
        if (wr == 1) PG8_BAR;
        PG8_WAIT_V(4); PG8_BAR;
        PG8_STAGE(PG8_SB(1, 0), cB + kstep, voffB); PG8_STAGE(PG8_SA(1, 0), cA + kstep, voffA); PG8_STAGE(PG8_SB(1, 1), cB + hstep + kstep, voffB);
        PG8_WAIT_V(6); PG8_BAR;
    }
    for (;;) {
        const bool has_next = S.next(ui + 1, nxt);
        const char* nA = has_next ? (const char*)g.A + (size_t)nxt.pm * tstep : cA; const char* nB = has_next ? (const char*)g.Bt + (size_t)nxt.pn * tstep : cB;
        for (int t = 0; t < nt; t += 2) {
            const bool last = (t == nt - 2);
            const char* a1 = cA + (size_t)(t + 1) * kstep;
            const char* a2 = last ? nA : cA + (size_t)(t + 2) * kstep; const char* b2 = last ? nB : cB + (size_t)(t + 2) * kstep;
            const char* a3 = a2 + kstep; const char* b3 = b2 + kstep;
            if (last && has_next) S.a_ready(nxt);
            if constexpr (SP2) {
            PG8_LDB(B0, 0, 0); PG8_LDB(B1, 0, 1); PG8_SCHED; PG8_LDA(At, 0, 0); PG8_STAGE(PG8_SA(1, 1), a1 + hstep, voffA);
            PG8_WAIT_V(8); PG8_WAIT_L(0); PG8_BAR; PG8_MMA(0, 0, At, B0); PG8_MMA(0, 1, At, B1); PG8_BAR; PG8_SCHED;
            PG8_LDA(At, 0, 1); PG8_STAGE(PG8_SB(0, 0), b2, voffB); PG8_STAGE(PG8_SB(0, 1), b2 + hstep, voffB); PG8_STAGE(PG8_SA(0, 0), a2, voffA);
            PG8_WAIT_V(8); PG8_WAIT_L(0); PG8_BAR; PG8_MMA(1, 0, At, B0); PG8_MMA(1, 1, At, B1); PG8_BAR; PG8_SCHED;
            PG8_LDB(B0, 1, 0); PG8_LDB(B1, 1, 1); PG8_SCHED; PG8_LDA(At, 1, 0); PG8_STAGE(PG8_SA(0, 1), a2 + hstep, voffA);
            PG8_WAIT_V(8); PG8_WAIT_L(0); PG8_BAR; PG8_MMA(0, 0, At, B0); PG8_MMA(0, 1, At, B1); PG8_BAR; PG8_SCHED;
            PG8_LDA(At, 1, 1); PG8_STAGE(PG8_SB(1, 0), b3, voffB); PG8_STAGE(PG8_SB(1, 1), b3 + hstep, voffB); PG8_STAGE(PG8_SA(1, 0), a3, voffA);
            PG8_WAIT_V(8); PG8_WAIT_L(0); PG8_BAR; PG8_MMA(1, 0, At, B0); PG8_MMA(1, 1, At, B1); PG8_BAR; PG8_SCHED;
            } else {
            PG8_LDB(B0, 0, 0); PG8_SCHED; PG8_LDA(At, 0, 0); PG8_STAGE(PG8_SA(1, 1), a1 + hstep, voffA);
            PG8_WAIT_L(8); PG8_BAR; PG8_WAIT_L(0); PG8_MMA(0, 0, At, B0); PG8_BAR; PG8_SCHED;
            PG8_LDB(B1, 0, 1); PG8_STAGE(PG8_SB(0, 0), b2, voffB);
            PG8_BAR; PG8_WAIT_L(0); PG8_MMA(0, 1, At, B1); PG8_BAR;
            PG8_LDA(At, 0, 1); PG8_STAGE(PG8_SA(0, 0), a2, voffA);
            PG8_BAR; PG8_WAIT_L(0); PG8_MMA(1, 0, At, B0); PG8_BAR; PG8_SCHED;
            PG8_STAGE(PG8_SB(0, 1), b2 + hstep, voffB);
            PG8_WAIT_V(6); PG8_BAR; PG8_MMA(1, 1, At, B1); PG8_BAR;
            PG8_LDB(B0, 1, 0); PG8_SCHED; PG8_LDA(At, 1, 0); PG8_STAGE(PG8_SA(0, 1), a2 + hstep, voffA);
            PG8_WAIT_L(8); PG8_BAR; PG8_WAIT_L(0); PG8_MMA(0, 0, At, B0); PG8_BAR; PG8_SCHED;
            PG8_LDB(B1, 1, 1); PG8_STAGE(PG8_SB(1, 0), b3, voffB);
            PG8_BAR; PG8_WAIT_L(0); PG8_MMA(0, 1, At, B1); PG8_BAR;
            PG8_LDA(At, 1, 1); PG8_STAGE(PG8_SA(1, 0), a3, voffA);
            PG8_BAR; PG8_WAIT_L(0); PG8_MMA(1, 0, At, B0); PG8_BAR; PG8_SCHED;
            PG8_STAGE(PG8_SB(1, 1), b3 + hstep, voffB);
            PG8_WAIT_V(6); PG8_BAR; PG8_MMA(1, 1, At, B1); PG8_BAR;
            }
        }
        if constexpr (ALIGN_EPI) { if (wr == 0) PG8_BAR; }
        if constexpr (!Epi::AFTER_DRAIN) { E(acc, cur, wr, wc, fr, fq); S.done(cur); }
        if (!has_next) break;
#pragma unroll
        for (int a = 0; a < 2; ++a)
#pragma unroll
            for (int b = 0; b < 2; ++b)
#pragma unroll
                for (int m = 0; m < 4; ++m)
#pragma unroll
                    for (int n = 0; n < 2; ++n) acc[a][b][m][n] = (f32x4){0.f, 0.f, 0.f, 0.f};
        cur = nxt; cA = nA; cB = nB; ++ui;
        if constexpr (ALIGN_EPI) { if (wr == 1) PG8_BAR; }
    }
    PG8_WAIT_V(0);
    if constexpr (!ALIGN_EPI) { if (wr == 0) PG8_BAR; }
    PG8_BAR;
    if constexpr (Epi::AFTER_DRAIN) { E.fused(acc, cur, wr, wc, fr, fq, lds, wid, lane); S.done(cur); }
#undef PG8_SA
#undef PG8_SB
#undef PG8_STAGE
#undef PG8_LDA
#undef PG8_LDB
#undef PG8_MMA
#undef PG8_WAIT_V
#undef PG8_WAIT_L
#undef PG8_BAR
#undef PG8_SCHED
}
}
constexpr int DM = 2048, DFF = 8192;
constexpr int CB = 32, CT = 256, LBT = 8, LT = 2048, PAST = 512;
constexpr int MC = CB * CT, ML = LBT * LT, MT = MC + ML;
constexpr int MKV = MT + LBT * PAST;
constexpr int EVEN_IN = 8192, ODD_IN = 1088, ODD_PAD = 1280;
constexpr float EPS = 1e-6f;
constexpr float LOG2E = 1.4426950408889634f;
constexpr size_t O_Y = 0, O_SF = (size_t)MT * DM, O_SB = O_SF + 4194304, O_NK = O_SB + 4194304, O_NV = O_NK + 8388608, O_CKV = O_NV + 8388608, O_KPE = O_CKV + 4194304, O_END = O_KPE + 524288;
constexpr size_t MiB = 1u << 20;
constexpr size_t WS_CTL = 0, CTL_ZERO_BYTES = 256 * 1024;
constexpr size_t WS_MOD = 1 * MiB;
constexpr size_t WS_ROPE = 2 * MiB;
constexpr size_t WS_BIAS = 3 * MiB;
constexpr size_t WS_MODP = 5 * MiB;
constexpr size_t WS_WINE = 19 * MiB, WS_WOUTE = 51 * MiB, WS_W1_0 = 59 * MiB, WS_W2_0 = 91 * MiB, WS_W1_1 = 123 * MiB, WS_W2_1 = 155 * MiB;
constexpr size_t WS_WINO = 187 * MiB, WS_WUQ = 192 * MiB, WS_WUKV = 195 * MiB, WS_WOUTO = 199 * MiB;
constexpr size_t WS_B = 207 * MiB;
constexpr size_t WS_C = 303 * MiB;
constexpr size_t WS_CKVX = WS_C + 144 * MiB;
constexpr size_t WS_D = 687 * MiB;
constexpr size_t WS_D_CQN = WS_D, WS_D_CKVN = WS_D + 24 * MiB, WS_D_KROT = WS_D + 52 * MiB;
constexpr size_t WS_D_NAK = WS_D, WS_D_NAV = WS_D + 8 * MiB;
constexpr size_t WS_END = 783 * MiB;
constexpr int CW_BAR = 4096, CW_Q0 = 8192, CW_Q1 = 8192 + 64;
constexpr int RING_BYTES = 155648, LDSCTL_OFF = RING_BYTES, MISC_OFF = LDSCTL_OFF + 320, LDS_BYTES = 163840;

#define GAS __attribute__((address_space(1)))
#define LAS __attribute__((address_space(3)))
typedef unsigned short bf16;
typedef unsigned v4u __attribute__((ext_vector_type(4)));
typedef unsigned v2u __attribute__((ext_vector_type(2)));
typedef float f32x4 __attribute__((ext_vector_type(4)));
typedef float f32x16 __attribute__((ext_vector_type(16)));
typedef short bf16x8 __attribute__((ext_vector_type(8)));
typedef short s16x4 __attribute__((ext_vector_type(4)));
typedef GAS unsigned gu32;
#define RLX_AGENT __ATOMIC_RELAXED, __HIP_MEMORY_SCOPE_AGENT
#define LDS_WAIT() asm volatile("s_waitcnt lgkmcnt(0)" ::: "memory")
#define VM_WAIT() asm volatile("s_waitcnt vmcnt(0)" ::: "memory")
__device__ __forceinline__ unsigned f2bf(float f) { unsigned u = __builtin_bit_cast(unsigned, f); return (u + 0x7fffu + ((u >> 16) & 1u)) >> 16; }
__device__ __forceinline__ unsigned pk2(float lo, float hi) { return f2bf(lo) | (f2bf(hi) << 16); }
__device__ __forceinline__ float bf2f(unsigned short b) { return __builtin_bit_cast(float, (unsigned)b << 16); }
__device__ __forceinline__ float bflo(unsigned w) { return __builtin_bit_cast(float, w << 16); }
__device__ __forceinline__ float bfhi(unsigned w) { return __builtin_bit_cast(float, w & 0xffff0000u); }
__device__ __forceinline__ float wave_sum(float v) {
#pragma unroll
    for (int o = 1; o < 64; o <<= 1) v += __shfl_xor(v, o);
    return v;
}
#define XB_TMO      128
#define XB_XCNT(j)  (256  + 64 * (j))
#define XB_XSUB(j)  (1280 + 64 * (j))
#define XB_XGEN(j)  (2304 + 64 * (j))
#define XB_TOP      3328
#define XB_TOPGEN   3392
#define XCD_BAR_WORDS 3456
#define XB_SPIN_CAP (1u << 18)

__device__ __forceinline__ unsigned xb_ld(unsigned* p)              { return __hip_atomic_load(p, __ATOMIC_RELAXED, __HIP_MEMORY_SCOPE_AGENT); }
__device__ __forceinline__ unsigned xb_add(unsigned* p, unsigned v) { return __hip_atomic_fetch_add(p, v, __ATOMIC_RELAXED, __HIP_MEMORY_SCOPE_AGENT); }
__device__ __forceinline__ unsigned xb_xcc_id() { return (unsigned)__builtin_amdgcn_s_getreg((3 << 11) | 20) & 0xFu; }
#define XB_SPIN(cond, bar) do { unsigned _sp = 0; while (cond) { __builtin_amdgcn_s_sleep(1); \
    if ((++_sp & 255u) == 0u) { if (xb_ld(&(bar)[XB_TMO])) break; if (_sp > XB_SPIN_CAP) { atomicAdd(&(bar)[XB_TMO], 1u); break; } } } } while (0)

struct XcdBarrier {
    unsigned* bar; unsigned x;
    volatile LAS unsigned* st;
};

__device__ __forceinline__ XcdBarrier xcd_barrier_post(unsigned* bar, volatile LAS unsigned* st) {
    XcdBarrier b; b.bar = bar; b.x = xb_xcc_id(); b.st = st;
    if (threadIdx.x == 0) (void)xb_add(&bar[XB_XCNT(b.x)], 1u);
    return b;
}
__device__ __forceinline__ void xcd_barrier_complete(unsigned* bar, unsigned x, unsigned& nloc, unsigned& nx) {
    const unsigned G = gridDim.x * gridDim.y * gridDim.z;
    unsigned sum, cnt, mine, sp = 0u;
    for (;;) {
        sum = 0u; cnt = 0u; mine = 0u;
#pragma unroll
        for (unsigned j = 0; j < 16; ++j) { const unsigned c = xb_ld(&bar[XB_XCNT(j)]); sum += c; cnt += (c > 0u) ? 1u : 0u; mine = (j == x) ? c : mine; }
        if (sum == G) break;
        __builtin_amdgcn_s_sleep(1);
        if ((++sp & 255u) == 0u) { if (xb_ld(&bar[XB_TMO])) break; if (sp > XB_SPIN_CAP) { atomicAdd(&bar[XB_TMO], 1u); break; } }
    }
    nloc = mine > 0u ? mine : 1u; nx = cnt > 0u ? cnt : 1u;
}

__device__ __forceinline__ void xcd_barrier(const XcdBarrier& b) {
    asm volatile("s_waitcnt vmcnt(0)" ::: "memory");
    __syncthreads();
    if (threadIdx.x == 0) {
        unsigned* bar = b.bar;
        __builtin_amdgcn_s_waitcnt(0);
        unsigned nloc = b.st[0], nx = b.st[1];
        if (nloc == 0u) { xcd_barrier_complete(bar, b.x, nloc, nx); b.st[0] = nloc; b.st[1] = nx; }
        const unsigned old = xb_add(&bar[XB_XSUB(b.x)], 1u);
        const unsigned gen = old / nloc;
        if (old + 1u == (gen + 1u) * nloc) {
            __builtin_amdgcn_fence(__ATOMIC_RELEASE, "agent");
            asm volatile("s_waitcnt vmcnt(0)" ::: "memory");
            const unsigned og = xb_add(&bar[XB_TOP], 1u);
            const unsigned tg = og / nx;
            if (og + 1u == (tg + 1u) * nx) xb_add(&bar[XB_TOPGEN], 1u);
            else XB_SPIN(xb_ld(&bar[XB_TOPGEN]) == tg, bar);
            __builtin_amdgcn_fence(__ATOMIC_ACQUIRE, "agent");
            xb_add(&bar[XB_XGEN(b.x)], 1u);
            asm volatile("s_waitcnt vmcnt(0)" ::: "memory");
        } else {
            XB_SPIN(xb_ld(&bar[XB_XGEN(b.x)]) == gen, bar);
            __builtin_amdgcn_fence(__ATOMIC_ACQUIRE, "agent");
            asm volatile("s_waitcnt vmcnt(0)" ::: "memory");
        }
    }
    __syncthreads();
}
struct Args { const float* in[27]; float* out; unsigned char* ws; int ph_lo, ph_hi, li, pad; };
enum { I_XP = 0, I_XS, I_SF, I_SB, I_NAK, I_NAV, I_CKV, I_KPE, I_C, I_CCTX, I_ADAW, I_ADAB, I_NG, I_LBF, I_LBB, I_WINE, I_HNG, I_RPB, I_WOUTE, I_WINO, I_QNG, I_WUQ, I_KVNG, I_WUKV, I_WOUTO, I_W1, I_W2 };

__device__ __forceinline__ void p0_transpose_item(const float* W, int K, int N, bf16* WT, LAS float* scr, int item, int lane) {
    const int nblk = N / 32, kb = item / nblk, nb = item % nblk, k0 = 64 * kb, n0 = 32 * nb;
#pragma unroll 8
    for (int i = 0; i < 32; ++i) { const int kk = 2 * i + (lane >> 5); scr[kk * 33 + (lane & 31)] = W[(size_t)(k0 + kk) * N + n0 + (lane & 31)]; }
    LDS_WAIT(); asm volatile("" ::: "memory");
    const int c = lane & 7;
#pragma unroll
    for (int j = 0; j < 4; ++j) { const int n = (lane >> 3) + 8 * j; const LAS float* s = scr + (8 * c) * 33 + n;
        v4u o; o.x = pk2(s[0 * 33], s[1 * 33]); o.y = pk2(s[2 * 33], s[3 * 33]); o.z = pk2(s[4 * 33], s[5 * 33]); o.w = pk2(s[6 * 33], s[7 * 33]);
        *(GAS v4u*)(WT + (size_t)(n0 + n) * K + k0 + 8 * c) = o; }
    LDS_WAIT(); asm volatile("" ::: "memory");
}

__device__ __forceinline__ void phase_prologue(const Args& a, LAS unsigned char* lds, int tid, int lane, int wave, int vcu, int G) {
    const int gw = vcu * 8 + wave, NGW = G * 8;
    unsigned char* ws = a.ws;
    {
        LAS float* scr = (LAS float*)(lds + wave * 16384);
        constexpr int I_A = 32 * 256, I_B = 32 * 64, I_C1 = 32 * 256, I_C2 = 128 * 64, I_D = 32 * 34, I_E = 8 * 96, I_F = 8 * 128, I_G = 32 * 64;
        constexpr int NITEMS = I_A + I_B + 2 * I_C1 + 2 * I_C2 + I_D + I_E + I_F + I_G;
        for (int it = gw; it < NITEMS; it += NGW) {
            int r = it;
            if (r < I_A) { p0_transpose_item(a.in[I_WINE], 2048, 8192, (bf16*)(ws + WS_WINE), scr, r, lane); continue; } r -= I_A;
            if (r < I_B) { p0_transpose_item(a.in[I_WOUTE], 2048, 2048, (bf16*)(ws + WS_WOUTE), scr, r, lane); continue; } r -= I_B;
            if (r < I_C1) { p0_transpose_item(a.in[I_W1], 2048, 8192, (bf16*)(ws + WS_W1_0), scr, r, lane); continue; } r -= I_C1;
            if (r < I_C1) { p0_transpose_item(a.in[I_W1] + (size_t)2048 * 8192, 2048, 8192, (bf16*)(ws + WS_W1_1), scr, r, lane); continue; } r -= I_C1;
            if (r < I_C2) { p0_transpose_item(a.in[I_W2], 8192, 2048, (bf16*)(ws + WS_W2_0), scr, r, lane); continue; } r -= I_C2;
            if (r < I_C2) { p0_transpose_item(a.in[I_W2] + (size_t)2048 * 8192, 8192, 2048, (bf16*)(ws + WS_W2_1), scr, r, lane); continue; } r -= I_C2;
            if (r < I_D) { p0_transpose_item(a.in[I_WINO], 2048, 1088, (bf16*)(ws + WS_WINO), scr, r, lane); continue; } r -= I_D;
            if (r < I_E) { p0_transpose_item(a.in[I_WUQ], 512, 3072, (bf16*)(ws + WS_WUQ), scr, r, lane); continue; } r -= I_E;
            if (r < I_F) { p0_transpose_item(a.in[I_WUKV], 512, 4096, (bf16*)(ws + WS_WUKV), scr, r, lane); continue; } r -= I_F;
            p0_transpose_item(a.in[I_WOUTO], 2048, 2048, (bf16*)(ws + WS_WOUTO), scr, r, lane);
        }
    }
    const size_t gt = (size_t)gw * 64 + lane, NGT = (size_t)NGW * 64;
    { GAS v4u* z = (GAS v4u*)(ws + WS_WINO + (size_t)1088 * 2048 * 2); for (size_t i = gt; i < (size_t)192 * 2048 * 2 / 16; i += NGT) z[i] = (v4u){0u, 0u, 0u, 0u}; }
    { float* bt = (float*)(ws + WS_BIAS); const float* rpb = a.in[I_RPB];
      for (size_t i = gt; i < (size_t)8 * 15 * 64 * 64; i += NGT) { const int kc = (int)(i & 63), qc = (int)((i >> 6) & 63), hd = (int)(i >> 12);
          int cs = qc - 8; cs = cs < 0 ? 0 : (cs > 48 ? 48 : cs); const bool ok = kc >= cs && kc < cs + 16; int ci = kc - qc + 15; ci = ci < 0 ? 0 : (ci > 30 ? 30 : ci);
          bt[i] = ok ? rpb[hd * 31 + ci] * 11.313708498984761f : -1e30f; } }
    { float* rt = (float*)(ws + WS_ROPE);
      for (size_t i = gt; i < 64 * 32; i += NGT) { const int pos = (int)(i >> 5), j = (int)(i & 31), i16 = j & 15; const float inv = powf(10000.f, -(float)(2 * i16) / 32.f); const float ang = (float)pos * inv;
          rt[i] = j < 16 ? cosf(ang) : sinf(ang); } }
    { const f32x4* sk = (const f32x4*)a.in[I_NAK]; const f32x4* sv = (const f32x4*)a.in[I_NAV]; GAS v2u* dk = (GAS v2u*)(ws + WS_D_NAK); GAS v2u* dv = (GAS v2u*)(ws + WS_D_NAV);
      for (size_t i = gt; i < (size_t)4194304 / 4; i += NGT) { const f32x4 x = sk[i], y = sv[i]; dk[i] = (v2u){pk2(x.x, x.y), pk2(x.z, x.w)}; dv[i] = (v2u){pk2(y.x, y.y), pk2(y.z, y.w)}; } }
    __syncthreads();
    {
        LAS float* S = (LAS float*)lds;
        for (int i = tid; i < 9 * 2048; i += 512) { const int r = i >> 11, k = i & 2047; const float x = r == 0 ? a.in[I_CCTX][k] : a.in[I_C][(r - 1) * 2048 + k]; S[k * 12 + r] = x / (1.f + __expf(-x)); }
        __syncthreads();
        float* modp = (float*)(ws + WS_MODP);
        for (int task = gw; task < 2 * 48 * 16; task += NGW) {
            const int l = task / 768, rem = task % 768, cg = rem >> 4, ks = rem & 15, col = cg * 256 + lane * 4;
            const float* W = a.in[I_ADAW] + ((size_t)l * 2048 + ks * 128) * 12288 + col;
            f32x4 acc[9];
#pragma unroll
            for (int r = 0; r < 9; ++r) acc[r] = (f32x4){0.f, 0.f, 0.f, 0.f};
#pragma unroll 4
            for (int kk = 0; kk < 128; ++kk) { const f32x4 w = *(const f32x4*)(W + (size_t)kk * 12288); const LAS f32x4* sp = (const LAS f32x4*)(S + (ks * 128 + kk) * 12);
                const f32x4 s0 = sp[0], s1 = sp[1], s2 = sp[2];
                acc[0] += w * s0.x; acc[1] += w * s0.y; acc[2] += w * s0.z; acc[3] += w * s0.w; acc[4] += w * s1.x; acc[5] += w * s1.y; acc[6] += w * s1.z; acc[7] += w * s1.w; acc[8] += w * s2.x; }
#pragma unroll
            for (int r = 0; r < 9; ++r) *(f32x4*)(modp + ((size_t)(l * 16 + ks) * 9 + r) * 12288 + col) = acc[r];
        }
    }
}

__device__ __forceinline__ void phase_mod_reduce(const Args& a, int gw, int lane, int NGW) {
    const float* modp = (const float*)(a.ws + WS_MODP); float* mod = (float*)(a.ws + WS_MOD);
    for (size_t i = (size_t)gw * 64 + lane; i < (size_t)2 * 9 * 12288; i += (size_t)NGW * 64) { const int l = (int)(i / 110592), rc = (int)(i % 110592), col = rc % 12288;
        float s = a.in[I_ADAB][l * 12288 + col];
#pragma unroll
        for (int ks = 0; ks < 16; ++ks) s += modp[(size_t)(l * 16 + ks) * 110592 + rc];
        mod[i] = s; }
}

template <bool POST, bool PRE>
__device__ __forceinline__ void row_pass(const float* xc, const float* xs, const bf16* y, float* xdst, bf16* hdst, const float* gpost, const float* gate0, const float* gpre, const float* shift0, const float* scale0,
                                         int gw, int lane, int NGW) {
    for (int m = gw; m < MT; m += NGW) {
        const int grp = m < MC ? 0 : 1 + ((m - MC) >> 11);
        const float* xr = (m < MC) ? xc + (size_t)m * DM : xs + (size_t)(m - MC) * DM;
        f32x4 v[8];
#pragma unroll
        for (int j = 0; j < 8; ++j) v[j] = *(const f32x4*)(xr + 4 * lane + 256 * j);
        if (POST) {
            const bf16* yr = y + (size_t)m * DM; f32x4 t[8]; float ss = 0.f;
#pragma unroll
            for (int j = 0; j < 8; ++j) { const v2u w = *(const v2u*)(yr + 4 * lane + 256 * j); t[j] = (f32x4){bflo(w.x), bfhi(w.x), bflo(w.y), bfhi(w.y)}; ss += (t[j].x * t[j].x + t[j].y * t[j].y) + (t[j].z * t[j].z + t[j].w * t[j].w); }
            const float rs = rsqrtf(wave_sum(ss) * (1.f / DM) + EPS);
            const float* gt = gate0 + (size_t)grp * 12288;
#pragma unroll
            for (int j = 0; j < 8; ++j) { const f32x4 g = *(const f32x4*)(gpost + 4 * lane + 256 * j), ga = *(const f32x4*)(gt + 4 * lane + 256 * j); v[j] = v[j] + ga * (t[j] * rs * g); }
            float* xo = xdst + (size_t)m * DM;
#pragma unroll
            for (int j = 0; j < 8; ++j) *(f32x4*)(xo + 4 * lane + 256 * j) = v[j];
        }
        if (PRE) {
            float ss = 0.f;
#pragma unroll
            for (int j = 0; j < 8; ++j) ss += (v[j].x * v[j].x + v[j].y * v[j].y) + (v[j].z * v[j].z + v[j].w * v[j].w);
            const float rs = rsqrtf(wave_sum(ss) * (1.f / DM) + EPS);
            const float* sh = shift0 + (size_t)grp * 12288; const float* sc = scale0 + (size_t)grp * 12288; bf16* ho = hdst + (size_t)m * DM;
#pragma unroll
            for (int j = 0; j < 8; ++j) { const f32x4 g = *(const f32x4*)(gpre + 4 * lane + 256 * j), s1 = *(const f32x4*)(sc + 4 * lane + 256 * j), s0 = *(const f32x4*)(sh + 4 * lane + 256 * j);
                const f32x4 o = (v[j] * rs * g) * (s1 + 1.f) + s0; *(v2u*)(ho + 4 * lane + 256 * j) = (v2u){pk2(o.x, o.y), pk2(o.z, o.w)}; }
        }
    }
}

__device__ __forceinline__ void phase_hgrn_combine(const Args& a, int gw, int lane, int NGW) {
    const float* ofw = a.out; const float* obw = a.out + (size_t)MT * 1024; const bf16* proj = (const bf16*)(a.ws + WS_C); bf16* ob = (bf16*)(a.ws + WS_B); const float* hng = a.in[I_HNG];
    const int c0 = lane * 16;
    for (int m = gw; m < MT; m += NGW) {
        f32x4 s[4]; float ss = 0.f;
#pragma unroll
        for (int j = 0; j < 4; ++j) { s[j] = *(const f32x4*)(ofw + (size_t)m * 1024 + c0 + 4 * j) + *(const f32x4*)(obw + (size_t)m * 1024 + c0 + 4 * j); ss += (s[j].x * s[j].x + s[j].y * s[j].y) + (s[j].z * s[j].z + s[j].w * s[j].w); }
        ss += __shfl_xor(ss, 1); ss += __shfl_xor(ss, 2); ss += __shfl_xor(ss, 4);
        const float rs = rsqrtf(ss * (1.f / 128.f) + EPS);
        const v4u g0 = *(const v4u*)(proj + (size_t)m * 8192 + 4096 + c0), g1 = *(const v4u*)(proj + (size_t)m * 8192 + 4096 + c0 + 8);
        float gv[16] = {bflo(g0.x), bfhi(g0.x), bflo(g0.y), bfhi(g0.y), bflo(g0.z), bfhi(g0.z), bflo(g0.w), bfhi(g0.w), bflo(g1.x), bfhi(g1.x), bflo(g1.y), bfhi(g1.y), bflo(g1.z), bfhi(g1.z), bflo(g1.w), bfhi(g1.w)};
        float o[16];
#pragma unroll
        for (int j = 0; j < 4; ++j) { const f32x4 gn = *(const f32x4*)(hng + (c0 & 127) + 4 * j);
#pragma unroll
            for (int e = 0; e < 4; ++e) { const float ga = gv[4 * j + e]; o[4 * j + e] = s[j][e] * rs * gn[e] * (ga / (1.f + __expf(-ga))); } }
        v4u w0 = {pk2(o[0], o[1]), pk2(o[2], o[3]), pk2(o[4], o[5]), pk2(o[6], o[7])}, w1 = {pk2(o[8], o[9]), pk2(o[10], o[11]), pk2(o[12], o[13]), pk2(o[14], o[15])};
        *(v4u*)(ob + (size_t)m * 2048 + c0) = w0; *(v4u*)(ob + (size_t)m * 2048 + c0 + 8) = w1;
    }
}

__device__ __forceinline__ void phase_mla_rows(const Args& a, int gw, int lane, int NGW) {
    const float* cqkv = (const float*)(a.ws + WS_C); bf16* cqn = (bf16*)(a.ws + WS_D_CQN); bf16* ckvn = (bf16*)(a.ws + WS_D_CKVN); bf16* krot = (bf16*)(a.ws + WS_D_KROT); const float* rope = (const float*)(a.ws + WS_ROPE);
    const f32x4 gq0 = *(const f32x4*)(a.in[I_QNG] + lane * 8), gq1 = *(const f32x4*)(a.in[I_QNG] + lane * 8 + 4), gk0 = *(const f32x4*)(a.in[I_KVNG] + lane * 8), gk1 = *(const f32x4*)(a.in[I_KVNG] + lane * 8 + 4);
    for (int m = gw; m < MT; m += NGW) {
        const float* r = cqkv + (size_t)m * ODD_PAD;
        { const f32x4 x0 = *(const f32x4*)(r + lane * 8), x1 = *(const f32x4*)(r + lane * 8 + 4);
          const float ss = (x0.x * x0.x + x0.y * x0.y) + (x0.z * x0.z + x0.w * x0.w) + (x1.x * x1.x + x1.y * x1.y) + (x1.z * x1.z + x1.w * x1.w);
          const float rs = rsqrtf(wave_sum(ss) * (1.f / 512.f) + EPS); const f32x4 o0 = x0 * rs * gq0, o1 = x1 * rs * gq1;
          *(v4u*)(cqn + (size_t)m * 512 + lane * 8) = (v4u){pk2(o0.x, o0.y), pk2(o0.z, o0.w), pk2(o1.x, o1.y), pk2(o1.z, o1.w)}; }
        { const f32x4 x0 = *(const f32x4*)(r + 512 + lane * 8), x1 = *(const f32x4*)(r + 512 + lane * 8 + 4);
          const float ss = (x0.x * x0.x + x0.y * x0.y) + (x0.z * x0.z + x0.w * x0.w) + (x1.x * x1.x + x1.y * x1.y) + (x1.z * x1.z + x1.w * x1.w);
          const float rs = rsqrtf(wave_sum(ss) * (1.f / 512.f) + EPS); const f32x4 o0 = x0 * rs * gk0, o1 = x1 * rs * gk1;
          *(v4u*)(ckvn + (size_t)m * 512 + lane * 8) = (v4u){pk2(o0.x, o0.y), pk2(o0.z, o0.w), pk2(o1.x, o1.y), pk2(o1.z, o1.w)};
          if (m < MC) { float* op = a.out + O_CKV + (size_t)m * 512 + lane * 8; *(f32x4*)op = o0; *(f32x4*)(op + 4) = o1; } }
        { const float x = r[1024 + lane];
          if (m < MC) { a.out[O_KPE + (size_t)m * 64 + lane] = x; krot[(size_t)m * 64 + lane] = (bf16)f2bf(x); }
          else { const int pos = (m - MC) & 2047, p = (lane >> 5) ? (pos & 63) : (pos >> 6), j = lane & 31, i16 = j & 15; const float c = rope[p * 32 + i16], s = rope[p * 32 + 16 + i16];
              const float pr = __shfl_xor(x, 16); const float yv = j < 16 ? x * c - pr * s : x * c + pr * s; krot[(size_t)m * 64 + lane] = (bf16)f2bf(yv); } }
    }
    for (int i = gw; i < LBT * PAST; i += NGW) {
        const f32x4 x0 = *(const f32x4*)(a.in[I_CKV] + (size_t)i * 512 + lane * 8), x1 = *(const f32x4*)(a.in[I_CKV] + (size_t)i * 512 + lane * 8 + 4);
        *(v4u*)(ckvn + (size_t)(MT + i) * 512 + lane * 8) = (v4u){pk2(x0.x, x0.y), pk2(x0.z, x0.w), pk2(x1.x, x1.y), pk2(x1.z, x1.w)};
        krot[(size_t)(MT + i) * 64 + lane] = (bf16)f2bf(a.in[I_KPE][(size_t)i * 64 + lane]);
    }
}
namespace hg {
#define KSWZ(row, colB) ((row) * 272 + (colB))
__device__ __forceinline__ int tsw(int row, int sB) { return row * 80 + sB; }
__device__ __forceinline__ int crow(int r, int hi) { return (r & 3) + 8 * (r >> 2) + 4 * hi; }
__device__ __forceinline__ unsigned cvtpk(float lo, float hi) { unsigned r; asm volatile("v_cvt_pk_bf16_f32 %0, %1, %2" : "=v"(r) : "v"(lo), "v"(hi)); return r; }
constexpr int B_QT = 0, B_KT = 8704, B_KTT = 17408, B_VT = 27648, B_SZ = 37888;

__device__ __forceinline__ void hgrn_pair(LAS unsigned char* lds, const Args& a, int type, int item0, int tid) {
    asm volatile("" : "+v"(tid));
    const int wid = __builtin_amdgcn_readfirstlane(tid >> 6), hw = wid >> 2, w4 = wid & 3, lane = tid & 63, r32 = lane & 31, hi = lane >> 5;
    const int item = item0 + hw, b = item >> 4, h = (item >> 1) & 7, dir = item & 1;
    const int T = type ? LT : CT, mbase = type ? MC + b * LT : b * CT, NC = T / 32;
    const bf16* proj = (const bf16*)(a.ws + WS_C);
    const int cq = h * 128, cf = (dir ? 2048 : 1024) + h * 128, ci = 3072 + h * 128;
    const int t256 = tid & 255, k = t256 & 127, th = __builtin_amdgcn_readfirstlane(t256 >> 7);
    LAS unsigned char* lb0 = lds + hw * 2 * B_SZ; LAS float* Dl0 = (LAS float*)(lds + LDSCTL_OFF + 1024 + hw * 1024);
    float lbv, oml;
    { const float* lbp = (dir ? a.in[I_LBB] : a.in[I_LBF]) + h * 128 + k; const float x0 = lbp[0], x1 = lbp[1024], x2 = lbp[2048]; const float mx = fmaxf(x0, fmaxf(x1, x2));
      const float e0 = __expf(x0 - mx), e1 = __expf(x1 - mx), e2 = __expf(x2 - mx); lbv = e0 / (e0 + e1 + e2); oml = 1.f - lbv; }
    f32x16 S[4];
    if (type) { const float* sp = (dir ? a.in[I_SB] : a.in[I_SF]) + (size_t)(b * 8 + h) * 16384 + 32 * w4 + r32;
#pragma unroll
        for (int kt = 0; kt < 4; ++kt)
#pragma unroll
            for (int r = 0; r < 16; ++r) S[kt][r] = sp[(32 * kt + crow(r, hi)) * 128]; }
    else {
#pragma unroll
        for (int kt = 0; kt < 4; ++kt) S[kt] = (f32x16){}; }
    typedef unsigned short us2 __attribute__((ext_vector_type(2)));
    us2 rf[16], rq[8]; v4u rv[2];
    const int vs = t256 & 31, vc = (t256 >> 5) * 8;
#define HLOAD(c_) do { \
        _Pragma("unroll") for (int i_ = 0; i_ < 16; ++i_) { const int p_ = (c_) * 32 + 16 * th + i_; const int t_ = dir ? T - 1 - p_ : p_; const bf16* rp_ = proj + (size_t)(mbase + t_) * 8192 + k; rq[i_ >> 1][i_ & 1] = rp_[cq]; rf[8 + (i_ >> 1)][i_ & 1] = rp_[cf]; } \
        if (th) { _Pragma("unroll") for (int i_ = 0; i_ < 16; ++i_) { const int p_ = (c_) * 32 + i_; const int t_ = dir ? T - 1 - p_ : p_; rf[i_ >> 1][i_ & 1] = proj[(size_t)(mbase + t_) * 8192 + cf + k]; } } \
        { const int p_ = (c_) * 32 + vs; const int t_ = dir ? T - 1 - p_ : p_; const bf16* rp_ = proj + (size_t)(mbase + t_) * 8192 + ci + vc; rv[0] = *(const v4u*)rp_; rv[1] = *(const v4u*)(rp_ + 64); } } while (0)
#define SIGF(raw_) (fmaf(oml, __builtin_amdgcn_rcpf(1.f + __builtin_amdgcn_exp2f(-LOG2E * bf2f(raw_))), lbv))
#define HPREP(bufi_) do { LAS unsigned char* B_ = lb0 + (bufi_) * B_SZ; float cp_ = 1.f; \
        if (th) { _Pragma("unroll") for (int i_ = 0; i_ < 16; ++i_) cp_ *= SIGF(rf[i_ >> 1][i_ & 1]); } \
        unsigned kw_[8]; float klo_ = 0.f; \
        _Pragma("unroll") for (int i_ = 0; i_ < 16; ++i_) { const int s_ = 16 * th + i_; const float f_ = SIGF(rf[8 + (i_ >> 1)][i_ & 1]); cp_ *= f_; const float cc_ = fmaxf(cp_, 1e-30f); \
            const float xq_ = bf2f(rq[i_ >> 1][i_ & 1]); const float qv_ = xq_ * __builtin_amdgcn_rcpf(1.f + __builtin_amdgcn_exp2f(-LOG2E * xq_)) * 0.08838834764831845f; \
            const float qt_ = qv_ * cc_, kt_ = (1.f - f_) * __builtin_amdgcn_rcpf(cc_); \
            *(LAS unsigned short*)(B_ + B_QT + KSWZ(s_, 2 * k)) = (unsigned short)f2bf(qt_); const unsigned kb_ = f2bf(kt_); *(LAS unsigned short*)(B_ + B_KT + KSWZ(s_, 2 * k)) = (unsigned short)kb_; \
            if (i_ & 1) kw_[i_ >> 1] = __builtin_bit_cast(unsigned, klo_) | (kb_ << 16); else klo_ = __builtin_bit_cast(float, kb_); \
            if ((i_ & 3) == 3) __builtin_amdgcn_sched_barrier(0); } \
        *(LAS v4u*)(B_ + B_KTT + tsw(k, 32 * th)) = (v4u){kw_[0], kw_[1], kw_[2], kw_[3]}; *(LAS v4u*)(B_ + B_KTT + tsw(k, 32 * th + 16)) = (v4u){kw_[4], kw_[5], kw_[6], kw_[7]}; \
        if (th) Dl0[(bufi_) * 128 + k] = fmaxf(cp_, 1e-30f); \
        _Pragma("unroll") for (int ps_ = 0; ps_ < 2; ++ps_) { const v4u x_ = rv[ps_]; const int c_ = vc + 64 * ps_; \
            *(LAS unsigned short*)(B_ + B_VT + tsw(c_ + 0, 2 * vs)) = (unsigned short)(x_.x & 0xffffu); *(LAS unsigned short*)(B_ + B_VT + tsw(c_ + 1, 2 * vs)) = (unsigned short)(x_.x >> 16); \
            *(LAS unsigned short*)(B_ + B_VT + tsw(c_ + 2, 2 * vs)) = (unsigned short)(x_.y & 0xffffu); *(LAS unsigned short*)(B_ + B_VT + tsw(c_ + 3, 2 * vs)) = (unsigned short)(x_.y >> 16); \
            *(LAS unsigned short*)(B_ + B_VT + tsw(c_ + 4, 2 * vs)) = (unsigned short)(x_.z & 0xffffu); *(LAS unsigned short*)(B_ + B_VT + tsw(c_ + 5, 2 * vs)) = (unsigned short)(x_.z >> 16); \
            *(LAS unsigned short*)(B_ + B_VT + tsw(c_ + 6, 2 * vs)) = (unsigned short)(x_.w & 0xffffu); *(LAS unsigned short*)(B_ + B_VT + tsw(c_ + 7, 2 * vs)) = (unsigned short)(x_.w >> 16); } } while (0)
    __syncthreads();
    HLOAD(0); HPREP(0); if (NC > 1) HLOAD(1);
    __syncthreads();
    float* odir = a.out + (dir ? (size_t)MT * 1024 : 0) + h * 128 + 32 * w4 + r32;
    for (int n = 0; n < NC; ++n) {
        const LAS unsigned char* Bf = lb0 + (n & 1) * B_SZ; const LAS float* Dl = Dl0 + (n & 1) * 128;
        f32x16 O = {};
#pragma unroll
        for (int kt = 0; kt < 4; ++kt)
#pragma unroll
            for (int st = 0; st < 2; ++st) {
                v4u w; w.x = cvtpk(S[kt][8 * st + 0], S[kt][8 * st + 1]); w.y = cvtpk(S[kt][8 * st + 2], S[kt][8 * st + 3]); w.z = cvtpk(S[kt][8 * st + 4], S[kt][8 * st + 5]); w.w = cvtpk(S[kt][8 * st + 6], S[kt][8 * st + 7]);
                const int cb = (32 * kt + 16 * st) * 2 + 8 * hi;
                const s16x4 q0 = *(const LAS s16x4*)(Bf + B_QT + KSWZ(r32, cb)), q1 = *(const LAS s16x4*)(Bf + B_QT + KSWZ(r32, cb + 16));
                const bf16x8 qa = (bf16x8){q0[0], q0[1], q0[2], q0[3], q1[0], q1[1], q1[2], q1[3]};
                O = __builtin_amdgcn_mfma_f32_32x32x16_bf16(qa, __builtin_bit_cast(bf16x8, w), O, 0, 0, 0);
            }
        f32x16 X = {};
#pragma unroll
        for (int d0 = 0; d0 < 8; ++d0) { const int cb = (d0 * 16 + hi * 8) * 2;
            const bf16x8 ka = *(const LAS bf16x8*)(Bf + B_KT + KSWZ(r32, cb)), qb = *(const LAS bf16x8*)(Bf + B_QT + KSWZ(r32, cb));
            X = __builtin_amdgcn_mfma_f32_32x32x16_bf16(ka, qb, X, 0, 0, 0); }
#pragma unroll
        for (int r = 0; r < 16; ++r) X[r] = (crow(r, hi) <= r32) ? X[r] : 0.f;
#pragma unroll
        for (int st = 0; st < 2; ++st) {
            v4u w; w.x = cvtpk(X[8 * st + 0], X[8 * st + 1]); w.y = cvtpk(X[8 * st + 2], X[8 * st + 3]); w.z = cvtpk(X[8 * st + 4], X[8 * st + 5]); w.w = cvtpk(X[8 * st + 6], X[8 * st + 7]);
            const int sB = 32 * st + 8 * hi, vrow = 32 * w4 + r32;
            const s16x4 v0 = *(const LAS s16x4*)(Bf + B_VT + tsw(vrow, sB)), v1 = *(const LAS s16x4*)(Bf + B_VT + tsw(vrow, sB + 16));
            const bf16x8 vb = (bf16x8){v0[0], v0[1], v0[2], v0[3], v1[0], v1[1], v1[2], v1[3]};
            O = __builtin_amdgcn_mfma_f32_32x32x16_bf16(__builtin_bit_cast(bf16x8, w), vb, O, 0, 0, 0);
        }
#pragma unroll
        for (int r = 0; r < 16; ++r) { const int p = n * 32 + crow(r, hi), t = dir ? T - 1 - p : p; odir[(size_t)(mbase + t) * 1024] = O[r]; }
#pragma unroll
        for (int st = 0; st < 2; ++st) { const int sB = 32 * st + 16 * hi;
            const bf16x8 vb = *(const LAS bf16x8*)(Bf + B_VT + tsw(32 * w4 + r32, sB));
#pragma unroll
            for (int kt = 0; kt < 4; ++kt) { const bf16x8 ka = *(const LAS bf16x8*)(Bf + B_KTT + tsw(32 * kt + r32, sB)); S[kt] = __builtin_amdgcn_mfma_f32_32x32x16_bf16(ka, vb, S[kt], 0, 0, 0); } }
#pragma unroll
        for (int kt = 0; kt < 4; ++kt)
#pragma unroll
            for (int g = 0; g < 4; ++g) { const f32x4 dv = *(const LAS f32x4*)(Dl + 32 * kt + 8 * g + 4 * hi); S[kt][4 * g] *= dv.x; S[kt][4 * g + 1] *= dv.y; S[kt][4 * g + 2] *= dv.z; S[kt][4 * g + 3] *= dv.w; }
        if (n + 1 < NC) { HPREP((n + 1) & 1); if (n + 2 < NC) HLOAD(n + 2); }
        __syncthreads();
    }
#undef HLOAD
#undef HPREP
#undef SIGF
    if (!type) { float* sp = a.out + (dir ? O_SB : O_SF) + (size_t)(b * 8 + h) * 16384 + 32 * w4 + r32;
#pragma unroll
        for (int kt = 0; kt < 4; ++kt)
#pragma unroll
            for (int r = 0; r < 16; ++r) sp[(32 * kt + crow(r, hi)) * 128] = S[kt][r]; }
}
#undef KSWZ
}

namespace att {
#define KSWZ(row, colB) ((row) * 256 + ((colB) ^ (((row) & 7) << 4)))
#define RSWZ(row, colB) ((row) * 128 + ((colB) ^ (((row) & 7) << 4)))
#define SBAR() __builtin_amdgcn_sched_barrier(0)
constexpr int L_V = 0, L_K = 32768, L_R = 65536, L_WS = 81920;
constexpr float THRL = 11.5f;
__device__ __forceinline__ int crow(int r, int hi) { return (r & 3) + 8 * (r >> 2) + 4 * hi; }
__device__ __forceinline__ unsigned cvtpk(float lo, float hi) { unsigned r; asm volatile("v_cvt_pk_bf16_f32 %0, %1, %2" : "=v"(r) : "v"(lo), "v"(hi)); return r; }
__device__ __forceinline__ int v_st(int k, int c) { const int kk = (k & ~0xC) | ((k & 4) << 1) | ((k & 8) >> 1); return ((kk >> 3) * 4 + (c >> 5)) * 512 + ((kk & 7) * 32 + (c & 31)) * 2; }
__device__ __forceinline__ int v_rd_base(int lane) { return ((lane & 3) << 3) | (((lane >> 2) & 3) << 6) | (((lane >> 4) & 1) << 5) | (((lane >> 5) & 1) << 8); }
constexpr int v_rd_off(int d0, int ks, int half) { return d0 * 512 + ks * 4096 + half * 2048; }
template <int OFF> __device__ __forceinline__ s16x4 tr_read(int vb) { s16x4 r; asm volatile("ds_read_b64_tr_b16 %0, %1 offset:%2" : "=&v"(r) : "v"(vb), "i"(OFF) : "memory"); return r; }
template <int D0> __device__ __forceinline__ void pv_one(f32x16& od, int vb, bf16x8 pa0, bf16x8 pa1, bf16x8 pa2, bf16x8 pa3) {
    const s16x4 l0 = tr_read<v_rd_off(D0, 0, 0)>(vb), h0 = tr_read<v_rd_off(D0, 0, 1)>(vb), l1 = tr_read<v_rd_off(D0, 1, 0)>(vb), h1 = tr_read<v_rd_off(D0, 1, 1)>(vb);
    const s16x4 l2 = tr_read<v_rd_off(D0, 2, 0)>(vb), h2 = tr_read<v_rd_off(D0, 2, 1)>(vb), l3 = tr_read<v_rd_off(D0, 3, 0)>(vb), h3 = tr_read<v_rd_off(D0, 3, 1)>(vb);
    asm volatile("s_waitcnt lgkmcnt(0)" ::: "memory"); SBAR();
#define PK(L, H) (bf16x8){L[0], L[1], L[2], L[3], H[0], H[1], H[2], H[3]}
    od = __builtin_amdgcn_mfma_f32_32x32x16_bf16(pa0, PK(l0, h0), od, 0, 0, 0);
    od = __builtin_amdgcn_mfma_f32_32x32x16_bf16(pa1, PK(l1, h1), od, 0, 0, 0);
    od = __builtin_amdgcn_mfma_f32_32x32x16_bf16(pa2, PK(l2, h2), od, 0, 0, 0);
    od = __builtin_amdgcn_mfma_f32_32x32x16_bf16(pa3, PK(l3, h3), od, 0, 0, 0);
#undef PK
}
struct Seg { const bf16* K; const bf16* V; const bf16* R; int ldk; int nt; };
struct Unit {
    const bf16* Q; int ldq; bf16* O; int ldo; Seg s0, s1;
    const float* rope; int pos0;
    const float* bias; int r0, rs;
    float C;
};
__device__ __forceinline__ bf16x8 ld8(const bf16* p) { return *(const bf16x8*)p; }

template <int DQK, bool NA>
__device__ __forceinline__ void attn_unit(LAS unsigned char* lds, const Unit& U, int tid) {
    asm volatile("" : "+v"(tid));
    const int wid = __builtin_amdgcn_readfirstlane(tid >> 6), lane = tid & 63, r32 = lane & 31, hi = lane >> 5;
    LAS float* wsl = (LAS float*)(lds + L_WS) + wid * 64; LAS float* li_l = wsl; LAS float* al_l = wsl + 32;
    float m_reg = -1e30f, l_reg = 0.f; f32x16 o[4] = {}; bf16x8 qr[DQK / 16];
    const bf16* Qw = U.Q + (size_t)(wid * 32 + r32) * U.ldq + hi * 8;
#pragma unroll
    for (int d0 = 0; d0 < 8; ++d0) qr[d0] = ld8(Qw + d0 * 16);
    if constexpr (DQK == 192) {
        bf16x8 e0 = ld8(Qw + 128), e1 = ld8(Qw + 144), e2 = ld8(Qw + 160), e3 = ld8(Qw + 176);
        if (U.rope) { const int pos = U.pos0 + wid * 32 + r32; const float* tr = U.rope + (pos >> 6) * 32 + hi * 8; const float* tc = U.rope + (pos & 63) * 32 + hi * 8;
            unsigned short a0[8], a1[8], a2[8], a3[8];
#pragma unroll
            for (int j = 0; j < 8; ++j) { float c = tr[j], s = tr[16 + j]; float x1 = bf2f((unsigned short)e0[j]), x2 = bf2f((unsigned short)e1[j]); a0[j] = (unsigned short)f2bf(x1 * c - x2 * s); a1[j] = (unsigned short)f2bf(x2 * c + x1 * s);
                c = tc[j]; s = tc[16 + j]; x1 = bf2f((unsigned short)e2[j]); x2 = bf2f((unsigned short)e3[j]); a2[j] = (unsigned short)f2bf(x1 * c - x2 * s); a3[j] = (unsigned short)f2bf(x2 * c + x1 * s); }
#pragma unroll
            for (int j = 0; j < 8; ++j) { e0[j] = (short)a0[j]; e1[j] = (short)a1[j]; e2[j] = (short)a2[j]; e3[j] = (short)a3[j]; } }
        qr[8] = e0; qr[9] = e1; qr[10] = e2; qr[11] = e3;
    }
    const int sr = tid >> 4, sc = (tid & 15) * 8, vst0 = v_st(sr, sc), vst1 = v_st(32 + sr, sc), rr = tid >> 3, rc = (tid & 7) * 8;
    const int vb0 = (int)(unsigned)(uintptr_t)(lds + L_V) + v_rd_base(lane);
    const int nt0 = U.s0.nt, NT = U.s0.nt + U.s1.nt;
    bf16x8 sv0, sv1, sk0, sk1, srp;
#define SLOAD(j_) do { const bool f_ = (j_) < nt0; const bf16* K_ = f_ ? U.s0.K : U.s1.K; const bf16* V_ = f_ ? U.s0.V : U.s1.V; const int ld_ = f_ ? U.s0.ldk : U.s1.ldk; const int k0_ = (f_ ? (j_) : (j_) - nt0) * 64; \
        const unsigned e0_ = (unsigned)((k0_ + sr) * ld_ + sc), e1_ = e0_ + 32u * (unsigned)ld_; \
        sv0 = ld8(V_ + e0_); sv1 = ld8(V_ + e1_); sk0 = ld8(K_ + e0_); sk1 = ld8(K_ + e1_); \
        if constexpr (DQK == 192) { const bf16* R_ = f_ ? U.s0.R : U.s1.R; srp = ld8(R_ + (unsigned)((k0_ + rr) * 64 + rc)); } } while (0)
#define SWRITE(b_) do { *(LAS bf16x8*)(lds + L_V + (b_) * 16384 + vst0) = sv0; *(LAS bf16x8*)(lds + L_V + (b_) * 16384 + vst1) = sv1; \
        *(LAS bf16x8*)(lds + L_K + (b_) * 16384 + KSWZ(sr, sc * 2)) = sk0; *(LAS bf16x8*)(lds + L_K + (b_) * 16384 + KSWZ(32 + sr, sc * 2)) = sk1; \
        if constexpr (DQK == 192) *(LAS bf16x8*)(lds + L_R + (b_) * 8192 + RSWZ(rr, rc * 2)) = srp; } while (0)
    SLOAD(0); VM_WAIT(); SWRITE(0); __syncthreads();
    const float C = U.C;
    for (int j = 0; j < NT; ++j) {
        const int b = j & 1;
        if (j + 1 < NT) SLOAD(j + 1);
        if constexpr (DQK == 192) { if (j == nt0 && U.rope) { qr[8] = ld8(Qw + 128); qr[9] = ld8(Qw + 144); qr[10] = ld8(Qw + 160); qr[11] = ld8(Qw + 176); } }
        bool valid = true; int dr = 0; const bool lat = NA && j < nt0;
        if (lat) { const int kr = U.rs + j, qrow = U.r0 + (wid >> 1); int w0 = qrow - 4; w0 = w0 < 0 ? 0 : (w0 > 24 ? 24 : w0); valid = kr >= w0 && kr < w0 + 8; dr = kr - qrow + 7; }
        if (valid) {
            f32x16 p0 = {}, p1 = {};
            if (lat) { const float* bp = U.bias + (unsigned)((dr * 64 + 32 * (wid & 1) + r32) * 64 + 4 * hi);
#pragma unroll
                for (int g = 0; g < 4; ++g) { const f32x4 x = *(const f32x4*)(bp + 8 * g), y = *(const f32x4*)(bp + 32 + 8 * g);
                    p0[4 * g] = x.x; p0[4 * g + 1] = x.y; p0[4 * g + 2] = x.z; p0[4 * g + 3] = x.w; p1[4 * g] = y.x; p1[4 * g + 1] = y.y; p1[4 * g + 2] = y.z; p1[4 * g + 3] = y.w; } }
            { const LAS unsigned char* Ks = lds + L_K + b * 16384;
#pragma unroll
              for (int d0 = 0; d0 < 8; ++d0) { const int cb = (d0 * 16 + hi * 8) * 2;
                  const bf16x8 b0 = *(const LAS bf16x8*)(Ks + KSWZ(r32, cb)), b1 = *(const LAS bf16x8*)(Ks + KSWZ(32 + r32, cb));
                  p0 = __builtin_amdgcn_mfma_f32_32x32x16_bf16(b0, qr[d0], p0, 0, 0, 0); p1 = __builtin_amdgcn_mfma_f32_32x32x16_bf16(b1, qr[d0], p1, 0, 0, 0);
                  if (d0 == 3) SBAR(); }
              if constexpr (DQK == 192) { const LAS unsigned char* Rs = lds + L_R + b * 8192;
#pragma unroll
                  for (int d0 = 0; d0 < 4; ++d0) { const int cb = (d0 * 16 + hi * 8) * 2;
                      const bf16x8 b0 = *(const LAS bf16x8*)(Rs + RSWZ(r32, cb)), b1 = *(const LAS bf16x8*)(Rs + RSWZ(32 + r32, cb));
                      p0 = __builtin_amdgcn_mfma_f32_32x32x16_bf16(b0, qr[8 + d0], p0, 0, 0, 0); p1 = __builtin_amdgcn_mfma_f32_32x32x16_bf16(b1, qr[8 + d0], p1, 0, 0, 0); } } }
#pragma unroll
            for (int r = 0; r < 16; ++r) { p0[r] *= C; p1[r] *= C; }
            float pmax = p0[0];
#pragma unroll
            for (int r = 1; r < 16; ++r) pmax = fmaxf(pmax, p0[r]);
#pragma unroll
            for (int r = 0; r < 16; ++r) pmax = fmaxf(pmax, p1[r]);
            { auto x = __builtin_amdgcn_permlane32_swap(__float_as_uint(pmax), __float_as_uint(pmax), false, false); pmax = fmaxf(__uint_as_float(x[0]), __uint_as_float(x[1])); }
            float alpha = 1.f;
            if (!__all(pmax - m_reg <= THRL)) { const float mn = fmaxf(m_reg, pmax); alpha = __builtin_amdgcn_exp2f(m_reg - mn); m_reg = mn; }
            float ps = 0.f;
#pragma unroll
            for (int r = 0; r < 16; ++r) { p0[r] = __builtin_amdgcn_exp2f(p0[r] - m_reg); p1[r] = __builtin_amdgcn_exp2f(p1[r] - m_reg); ps += p0[r] + p1[r]; }
            { auto x = __builtin_amdgcn_permlane32_swap(__float_as_uint(ps), __float_as_uint(ps), false, false); ps = __uint_as_float(x[0]) + __uint_as_float(x[1]); }
            l_reg = l_reg * alpha + ps;
            bf16x8 pa0, pa1, pa2, pa3;
#define PK4(P, BASE, OUT) do { unsigned a0 = cvtpk(P[BASE + 0], P[BASE + 1]), a1 = cvtpk(P[BASE + 2], P[BASE + 3]); unsigned b0 = cvtpk(P[BASE + 4], P[BASE + 5]), b1 = cvtpk(P[BASE + 6], P[BASE + 7]); \
        auto r0 = __builtin_amdgcn_permlane32_swap(a0, b0, false, false); auto r1 = __builtin_amdgcn_permlane32_swap(a1, b1, false, false); \
        v4u w = {r0[0], r1[0], r0[1], r1[1]}; OUT = __builtin_bit_cast(bf16x8, w); } while (0)
            PK4(p0, 0, pa0); PK4(p0, 8, pa1); PK4(p1, 0, pa2); PK4(p1, 8, pa3);
#undef PK4
            if (__any(alpha < 1.f)) { if (hi == 0) al_l[r32] = alpha; LDS_WAIT();
#pragma unroll
                for (int r = 0; r < 16; ++r) { const float av = al_l[crow(r, hi)];
#pragma unroll
                    for (int d = 0; d < 4; ++d) o[d][r] *= av; } }
            const int vb = vb0 + b * 16384;
            pv_one<0>(o[0], vb, pa0, pa1, pa2, pa3); pv_one<1>(o[1], vb, pa0, pa1, pa2, pa3); pv_one<2>(o[2], vb, pa0, pa1, pa2, pa3); pv_one<3>(o[3], vb, pa0, pa1, pa2, pa3);
        }
        if (j + 1 < NT) { VM_WAIT(); SWRITE(b ^ 1); }
        __syncthreads();
    }
#undef SLOAD
#undef SWRITE
    if (hi == 0) li_l[r32] = l_reg;
    LDS_WAIT();
    bf16* Ow = U.O + (size_t)(wid * 32) * U.ldo;
#pragma unroll
    for (int r = 0; r < 16; ++r) { const int orow = crow(r, hi); const float rl = 1.f / li_l[orow];
#pragma unroll
        for (int d0 = 0; d0 < 4; ++d0) Ow[(size_t)orow * U.ldo + d0 * 32 + r32] = (bf16)f2bf(o[d0][r] * rl); }
}
#undef KSWZ
#undef RSWZ
#undef SBAR
}
constexpr int NPHASE = 20;
#ifndef PROBE_REP0
#define PROBE_REP0 1
#endif
#ifndef PROBE_REP4
#define PROBE_REP4 1
#endif
#ifndef PROBE_REP14
#define PROBE_REP14 1
#endif
__device__ __forceinline__ unsigned queue_next(LAS unsigned char* lds, gu32* ctr, int tid) {
    LAS unsigned* qw = (LAS unsigned*)(lds + LDSCTL_OFF + 64);
    __syncthreads();
    if (tid == 0) *qw = __hip_atomic_fetch_add(ctr, 1u, RLX_AGENT);
    __syncthreads();
    return (unsigned)__builtin_amdgcn_readfirstlane((int)*qw);
}

__device__ __forceinline__ void phase_even_mixers(const Args& args, LAS unsigned char* lds, gu32* qctr, int tid, int vcu, int G) {
    unsigned char* ws = args.ws; bf16* Bbuf = (bf16*)(ws + WS_B); bf16* Cbuf = (bf16*)(ws + WS_C);

        { const bool fast = G >= 128; int pr = fast ? (vcu < 64 ? vcu : 64 + (vcu - 64)) : vcu; const int step = fast ? (vcu < 64 ? 1024 : G - 64) : G;
          for (; pr < 320; pr += step) hg::hgrn_pair(lds, args, pr < 64 ? 1 : 0, pr < 64 ? 2 * pr : 2 * (pr - 64), tid); }
        const bf16* nak = (const bf16*)(ws + WS_D_NAK); const bf16* nav = (const bf16*)(ws + WS_D_NAV); const float* bt = (const float*)(ws + WS_BIAS);
        for (;;) {
            const unsigned u = queue_next(lds, qctr, tid);
            if (u >= 768u) break;
            att::Unit U; U.ldq = 8192; U.ldo = 2048; U.rope = nullptr; U.pos0 = 0; U.C = 0.08838834764831845f * LOG2E;
            if (u < 512u) { const int b = u >> 6, h = (u >> 3) & 7, qb = u & 7; const size_t row0 = (size_t)MC + b * LT + qb * 256;
                const int r0 = 4 * qb; int rs = r0 - 4; rs = rs < 0 ? 0 : (rs > 24 ? 24 : rs); int re = r0 - 1; re = re < 0 ? 0 : (re > 24 ? 24 : re); re += 8;
                U.Q = Cbuf + row0 * 8192 + 5120 + h * 128; U.O = Bbuf + row0 * 2048 + 1024 + h * 128;
                const bf16* kb = Cbuf + ((size_t)MC + b * LT + rs * 64) * 8192 + 6144 + h * 128;
                U.s0 = att::Seg{kb, kb + 1024, nullptr, 8192, re - rs};
                U.s1 = att::Seg{nak + (size_t)b * 512 * 1024 + h * 128, nav + (size_t)b * 512 * 1024 + h * 128, nullptr, 1024, 8};
                U.bias = bt + (size_t)h * 15 * 4096; U.r0 = r0; U.rs = rs;
                att::attn_unit<128, true>(lds, U, tid); }
            else { const int i = u - 512, b = i >> 3, h = i & 7; const size_t row0 = (size_t)b * CT;
                U.Q = Cbuf + row0 * 8192 + 5120 + h * 128; U.O = Bbuf + row0 * 2048 + 1024 + h * 128;
                const bf16* kb = Cbuf + row0 * 8192 + 6144 + h * 128;
                U.s0 = att::Seg{kb, kb + 1024, nullptr, 8192, 4}; U.s1 = att::Seg{kb, kb + 1024, nullptr, 8192, 0}; U.bias = nullptr; U.r0 = 0; U.rs = 0;
                att::attn_unit<128, false>(lds, U, tid); }
        }
}

__device__ __forceinline__ void phase_mla_attn(const Args& args, LAS unsigned char* lds, gu32* qctr, int tid) {
    unsigned char* ws = args.ws; bf16* Bbuf = (bf16*)(ws + WS_B); bf16* Cbuf = (bf16*)(ws + WS_C);

        const bf16* qb_ = Cbuf; const bf16* kv = (const bf16*)(ws + WS_CKVX); const bf16* krot = (const bf16*)(ws + WS_D_KROT); const float* rope = (const float*)(ws + WS_ROPE);
        for (;;) {
            const unsigned u = queue_next(lds, qctr, tid);
            if (u >= 1536u) break;
            att::Unit U; U.ldq = 3072; U.ldo = 2048; U.bias = nullptr; U.r0 = 0; U.rs = 0; U.C = 0.07216878364870322f * LOG2E;
            if (u < 1024u) { const int b = u >> 7, h = (u >> 3) & 15, qb = u & 7; const size_t row0 = (size_t)MC + b * LT + qb * 256;
                U.Q = qb_ + row0 * 3072 + h * 192; U.O = Bbuf + row0 * 2048 + h * 128; U.rope = rope; U.pos0 = qb * 256;
                const bf16* kb = kv + ((size_t)MC + b * LT) * 4096 + h * 256; const bf16* kc = kv + ((size_t)MT + b * PAST) * 4096 + h * 256;
                U.s0 = att::Seg{kb, kb + 128, krot + ((size_t)MC + b * LT) * 64, 4096, 32}; U.s1 = att::Seg{kc, kc + 128, krot + ((size_t)MT + b * PAST) * 64, 4096, 8}; }
            else { const int i = u - 1024, b = i >> 4, h = i & 15; const size_t row0 = (size_t)b * CT;
                U.Q = qb_ + row0 * 3072 + h * 192; U.O = Bbuf + row0 * 2048 + h * 128; U.rope = nullptr; U.pos0 = 0;
                const bf16* kb = kv + row0 * 4096 + h * 256;
                U.s0 = att::Seg{kb, kb + 128, krot + row0 * 64, 4096, 4}; U.s1 = att::Seg{kb, kb + 128, krot + row0 * 64, 4096, 0}; }
            att::attn_unit<192, false>(lds, U, tid);
        }
}

__global__ void __launch_bounds__(512, 2) mega_fwd(Args args) {
    extern __shared__ __attribute__((aligned(16))) unsigned char lds_raw[];
    LAS unsigned char* lds = (LAS unsigned char*)lds_raw;
    const int tid = threadIdx.x, lane = tid & 63, wave = __builtin_amdgcn_readfirstlane(tid >> 6);
    const int G = gridDim.x; const int bx = blockIdx.x; const int vcu = (G % 8 == 0) ? (bx % 8) * (G / 8) + bx / 8 : bx;
    const int gw = vcu * 8 + wave, NGW = G * 8;
    unsigned char* ws = args.ws;
    gu32* ctl = (gu32*)(ws + WS_CTL);
    for (int u = tid; u < (LDS_BYTES - LDSCTL_OFF) / 4; u += 512) ((LAS unsigned*)(lds + LDSCTL_OFF))[u] = 0u;
    __syncthreads();
    volatile LAS unsigned* MISC = (volatile LAS unsigned*)(lds + MISC_OFF);
    XcdBarrier bar = xcd_barrier_post((unsigned*)(ws + WS_CTL) + CW_BAR + args.li * XCD_BAR_WORDS, MISC + 8);
    const int lo = args.ph_lo, hi = args.ph_hi;
#define IN(k) (lo <= (k) && (k) < hi)
#define SEAM(k) do { if (IN(k) && IN((k) + 1)) xcd_barrier(bar); } while (0)
    bf16* Bbuf = (bf16*)(ws + WS_B); bf16* Cbuf = (bf16*)(ws + WS_C); bf16* Dbuf = (bf16*)(ws + WS_D);
    const float* mod = (const float*)(ws + WS_MOD);
    const float* ng = args.in[I_NG];

    if (IN(0)) { phase_prologue(args, lds, tid, lane, wave, vcu, G);
#if PROBE_REP0 == 2
        xcd_barrier(bar); phase_prologue(args, lds, tid, lane, wave, vcu, G);
#endif
    }
    SEAM(0);
    if (IN(1)) phase_mod_reduce(args, gw, lane, NGW);
    SEAM(1);
    if (IN(2)) row_pass<false, true>(args.in[I_XP], args.in[I_XS], nullptr, nullptr, Bbuf, nullptr, nullptr, ng, mod, mod + 2048, gw, lane, NGW);
    SEAM(2);
    if (IN(3)) { pg8::Gemm g{Bbuf, (const bf16*)(ws + WS_WINE), MT, EVEN_IN, DM}; pg8::StaticOrder S; S.init(MT, EVEN_IN, G, bx);
        pg8::EpiT<3> E{Cbuf, EVEN_IN, nullptr, 0, args.out + O_NK, args.out + O_NV};
        pg8::gemm_phase<pg8::EpiT<3>, pg8::StaticOrder, true, true>(lds, g, S, E); }
    SEAM(3);
    if (IN(4)) { phase_even_mixers(args, lds, ctl + CW_Q0, tid, vcu, G);
#if PROBE_REP4 == 2
        xcd_barrier(bar); phase_even_mixers(args, lds, ctl + CW_Q0 + 128, tid, vcu, G);
#endif
    }
    SEAM(4);
    if (IN(5)) phase_hgrn_combine(args, gw, lane, NGW);
    SEAM(5);
    if (IN(6)) { pg8::Gemm g{Bbuf, (const bf16*)(ws + WS_WOUTE), MT, DM, DM}; pg8::StaticOrder S; S.init(MT, DM, G, bx); pg8::EpiT<0> E{Dbuf, DM, nullptr, 0, nullptr, nullptr};
        pg8::gemm_phase<pg8::EpiT<0>, pg8::StaticOrder, true, true>(lds, g, S, E); }
    SEAM(6);
    if (IN(7)) row_pass<true, true>(args.in[I_XP], args.in[I_XS], Dbuf, args.out, Bbuf, ng + 2048, mod + 2 * 2048, ng + 2 * 2048, mod + 3 * 2048, mod + 4 * 2048, gw, lane, NGW);
    SEAM(7);
    if (IN(8)) { pg8::Gemm g{Bbuf, (const bf16*)(ws + WS_W1_0), MT, DFF, DM}; pg8::StaticOrder S; S.init(MT, DFF, G, bx); pg8::EpiT<1> E{Cbuf, DFF, nullptr, 0, nullptr, nullptr};
        pg8::gemm_phase<pg8::EpiT<1>, pg8::StaticOrder, true, true>(lds, g, S, E); }
    SEAM(8);
    if (IN(9)) { pg8::Gemm g{Cbuf, (const bf16*)(ws + WS_W2_0), MT, DM, DFF}; pg8::StaticOrder S; S.init(MT, DM, G, bx); pg8::EpiT<0> E{Dbuf, DM, nullptr, 0, nullptr, nullptr};
        pg8::gemm_phase<pg8::EpiT<0>, pg8::StaticOrder, true, true>(lds, g, S, E); }
    SEAM(9);
    if (IN(10)) row_pass<true, true>(args.out, args.out + (size_t)MC * DM, Dbuf, args.out, Bbuf, ng + 3 * 2048, mod + 5 * 2048, ng + 4 * 2048, mod + 110592, mod + 110592 + 2048, gw, lane, NGW);
    SEAM(10);
    if (IN(11)) { pg8::Gemm g{Bbuf, (const bf16*)(ws + WS_WINO), MT, ODD_PAD, DM}; pg8::StaticOrder S; S.init(MT, ODD_PAD, G, bx); pg8::EpiT<2> E{nullptr, 0, (float*)(ws + WS_C), ODD_PAD, nullptr, nullptr};
        pg8::gemm_phase<pg8::EpiT<2>, pg8::StaticOrder, true, true>(lds, g, S, E); }
    SEAM(11);
    if (IN(12)) phase_mla_rows(args, gw, lane, NGW);
    SEAM(12);
    if (IN(13)) {
        { pg8::Gemm g{(const bf16*)(ws + WS_D_CQN), (const bf16*)(ws + WS_WUQ), MT, 3072, 512}; pg8::StaticOrder S; S.init(MT, 3072, G, bx); pg8::EpiT<0> E{Cbuf, 3072, nullptr, 0, nullptr, nullptr};
          pg8::gemm_phase<pg8::EpiT<0>, pg8::StaticOrder, true, true>(lds, g, S, E); }
        { pg8::Gemm g{(const bf16*)(ws + WS_D_CKVN), (const bf16*)(ws + WS_WUKV), MKV, 4096, 512}; pg8::StaticOrder S; S.init(MKV, 4096, G, bx); pg8::EpiT<0> E{(bf16*)(ws + WS_CKVX), 4096, nullptr, 0, nullptr, nullptr};
          pg8::gemm_phase<pg8::EpiT<0>, pg8::StaticOrder, true, true>(lds, g, S, E); }
    }
    SEAM(13);
    if (IN(14)) { phase_mla_attn(args, lds, ctl + CW_Q1, tid);
#if PROBE_REP14 == 2
        xcd_barrier(bar); phase_mla_attn(args, lds, ctl + CW_Q1 + 128, tid);
#endif
    }
    SEAM(14);
    if (IN(15)) { pg8::Gemm g{Bbuf, (const bf16*)(ws + WS_WOUTO), MT, DM, DM}; pg8::StaticOrder S; S.init(MT, DM, G, bx); pg8::EpiT<0> E{Dbuf, DM, nullptr, 0, nullptr, nullptr};
        pg8::gemm_phase<pg8::EpiT<0>, pg8::StaticOrder, true, true>(lds, g, S, E); }
    SEAM(15);
    { const float* mod1 = mod + 110592; const float* ng1 = ng + 4 * 2048;
    if (IN(16)) row_pass<true, true>(args.out, args.out + (size_t)MC * DM, Dbuf, args.out, Bbuf, ng1 + 2048, mod1 + 2 * 2048, ng1 + 2 * 2048, mod1 + 3 * 2048, mod1 + 4 * 2048, gw, lane, NGW);
    SEAM(16);
    if (IN(17)) { pg8::Gemm g{Bbuf, (const bf16*)(ws + WS_W1_1), MT, DFF, DM}; pg8::StaticOrder S; S.init(MT, DFF, G, bx); pg8::EpiT<1> E{Cbuf, DFF, nullptr, 0, nullptr, nullptr};
        pg8::gemm_phase<pg8::EpiT<1>, pg8::StaticOrder, true, true>(lds, g, S, E); }
    SEAM(17);
    if (IN(18)) { pg8::Gemm g{Cbuf, (const bf16*)(ws + WS_W2_1), MT, DM, DFF}; pg8::StaticOrder S; S.init(MT, DM, G, bx); pg8::EpiT<0> E{Dbuf, DM, nullptr, 0, nullptr, nullptr};
        pg8::gemm_phase<pg8::EpiT<0>, pg8::StaticOrder, true, true>(lds, g, S, E); }
    SEAM(18);
    if (IN(19)) row_pass<true, false>(args.out, args.out + (size_t)MC * DM, Dbuf, args.out, nullptr, ng1 + 3 * 2048, mod1 + 5 * 2048, nullptr, nullptr, nullptr, gw, lane, NGW);
    }
#undef IN
#undef SEAM
}

#ifndef MK_SPLITS
#define MK_SPLITS 1
#endif
extern "C" void kernel_launch(void* const* d_in, const int* in_sizes, int n_in, void* d_out, int out_size, void* d_ws, size_t ws_size, hipStream_t stream) {
    static int grid = 0;
    if (grid == 0) {
        if (n_in != 27 || (size_t)out_size != O_END || ws_size < WS_END) { fprintf(stderr, "kernel_launch: shape mismatch n_in %d out %d ws %zu (need %zu)\n", n_in, out_size, ws_size, (size_t)WS_END); grid = -1; return; }
        int dev = 0, cus = 0, per_cu = 0;
        if (hipGetDevice(&dev) != hipSuccess || hipDeviceGetAttribute(&cus, hipDeviceAttributeMultiprocessorCount, dev) != hipSuccess) { grid = -1; return; }
        if (hipFuncSetAttribute((const void*)mega_fwd, hipFuncAttributeMaxDynamicSharedMemorySize, LDS_BYTES) != hipSuccess) { fprintf(stderr, "kernel_launch: hipFuncSetAttribute failed\n"); grid = -1; return; }
        if (hipOccupancyMaxActiveBlocksPerMultiprocessor(&per_cu, (const void*)mega_fwd, 512, LDS_BYTES) != hipSuccess || per_cu < 1) { fprintf(stderr, "kernel_launch: occupancy query says %d\n", per_cu); }
        (void)hipGetLastError();
        grid = cus;
    }
    if (grid < 0) return;
    (void)hipMemsetAsync((char*)d_ws + WS_CTL, 0, CTL_ZERO_BYTES, stream);
    Args a{};
    for (int i = 0; i < 27; ++i) a.in[i] = (const float*)d_in[i];
    a.out = (float*)d_out; a.ws = (unsigned char*)d_ws; a.pad = 0;
#if MK_SPLITS == 1
    a.ph_lo = 0; a.ph_hi = NPHASE; a.li = 0;
    hipLaunchKernelGGL(mega_fwd, dim3(grid), dim3(512), LDS_BYTES, stream, a);
#else
    for (int k = 0; k < NPHASE; ++k) { a.ph_lo = k; a.ph_hi = k + 1; a.li = 0; hipLaunchKernelGGL(mega_fwd, dim3(grid), dim3(512), LDS_BYTES, stream, a); }
#endif
}
```

```cpp
#include <hip/hip_runtime.h>
#include <cstdio>
#include <cstdint>
namespace pg8 {
#define PG8_LAS __attribute__((address_space(3)))
typedef unsigned short bf16_t;
typedef short bf16x8 __attribute__((ext_vector_type(8)));
typedef float f32x4 __attribute__((ext_vector_type(4)));
typedef unsigned u32x4 __attribute__((ext_vector_type(4)));
constexpr int BM = 256, BK = 64, HALF = 128, HTB = HALF * BK * 2  , STAGE_BYTES = 8 * HTB, NXCD = 8, WGM = 8;

__host__ __device__ __forceinline__ int lds_byte(int r, int c) { const int st = (r >> 4) * 2 + (c >> 5), rr = r & 15, cc = c & 31, ob = rr * 64 + cc * 2; return st * 1024 + (ob ^ (((ob >> 9) & 1) << 5)); }
__host__ __device__ __forceinline__ void stage_rc(int b, int& R, int& C) { const int st = b / 1024, sb = b % 1024, swz = sb ^ (((sb >> 9) & 1) << 5); R = (st >> 1) * 16 + swz / 64; C = (st & 1) * 32 + (swz % 64) / 2; }
__host__ __device__ __forceinline__ int perm32(int rho) { const int n = rho >> 4, i = rho & 15; return 8 * (i >> 2) + 4 * n + (i & 3); }

struct Unit { int pm, pn; };
struct Gemm { const bf16_t* A; const bf16_t* Bt; int M, N, K; };

struct StaticOrder {
    int nM, nN, nwg, G, c;
    __host__ __device__ void init(int M, int N, int G_, int c_) { nM = M / BM; nN = N / BM; nwg = nM * nN; G = G_; c = c_; }
    __host__ __device__ bool next(int i, Unit& u) const {
        const long L = (long)i * G + c; if (L >= nwg) return false;
        int wgid = (int)L; { const int q = nwg / NXCD, r = nwg % NXCD, xcd = wgid % NXCD, off = wgid / NXCD; wgid = (xcd < r ? xcd * (q + 1) : r * (q + 1) + (xcd - r) * q) + off; }
        const int nig = WGM * nN, gid = wgid / nig, fm = gid * WGM, gsz = (nM - fm) < WGM ? (nM - fm) : WGM;
        u.pm = fm + ((wgid % nig) % gsz); u.pn = (wgid % nig) / gsz; return true;
    }
    __device__ __forceinline__ void a_ready(const Unit&) const {}
    __device__ __forceinline__ void done(const Unit&) const {}
};

__device__ __forceinline__ unsigned cvt_pk_bf16(float lo, float hi) { unsigned r; asm volatile("v_cvt_pk_bf16_f32 %0, %1, %2" : "=v"(r) : "v"(lo), "v"(hi)); return r; }
typedef float f32x2 __attribute__((ext_vector_type(2)));
template <int MODE> struct EpiT {
    static constexpr bool PERM = true, AFTER_DRAIN = false;
    bf16_t* O; int ldc; float* F; int ldf; float* side_k; float* side_v; bf16_t* O2; const float* side_lb;
    __device__ __forceinline__ void operator()(const f32x4 (&acc)[2][2][4][2], const Unit& u, int wr, int wc, int fr, int fq) const {
        const int row0 = u.pm * BM + wr * 64 + fr; const int col0 = u.pn * BM + wc * 32 + 8 * fq;
#pragma unroll
        for (int ai = 0; ai < 2; ++ai)
#pragma unroll
            for (int m = 0; m < 4; ++m) { const int row = row0 + ai * HALF + m * 16;
#pragma unroll
                for (int bj = 0; bj < 2; ++bj) { f32x4 v0 = acc[ai][bj][m][0], v1 = acc[ai][bj][m][1]; const int col = col0 + bj * HALF;
                    if (MODE == 1) {
#pragma unroll
                        for (int e = 0; e < 4; ++e) { float a = v0[e] > 0.f ? v0[e] : 0.f; v0[e] = a * a; float b = v1[e] > 0.f ? v1[e] : 0.f; v1[e] = b * b; } }
                    if (MODE == 2) { float* fp = F + (size_t)row * ldf + col; *(f32x4*)fp = v0; *(f32x4*)(fp + 4) = v1; }
                    else { u32x4 w; w.x = cvt_pk_bf16(v0[0], v0[1]); w.y = cvt_pk_bf16(v0[2], v0[3]); w.z = cvt_pk_bf16(v1[0], v1[1]); w.w = cvt_pk_bf16(v1[2], v1[3]);
                        if (MODE == 3) {
                            if (col < 4096) { const int kind = col >> 10, hh = (col >> 7) & 7, cc = col & 127; const bool ctxr = row < 8192; const int T = ctxr ? 256 : 2048; const int t = ctxr ? (row & 255) : ((row - 8192) & 2047);
                                unsigned char* tp = (unsigned char*)O + ((size_t)(row - t) * 8 + (size_t)(hh * T + t)) * 1536;
                                if (kind == 0) { float q[8] = {v0[0], v0[1], v0[2], v0[3], v1[0], v1[1], v1[2], v1[3]};
#pragma unroll
                                    for (int e = 0; e < 8; ++e) q[e] = q[e] * __builtin_amdgcn_rcpf(1.f + __builtin_amdgcn_exp2f(-1.4426950408889634f * q[e])) * 0.08838834764831845f;
                                    u32x4 wq; wq.x = cvt_pk_bf16(q[0], q[1]); wq.y = cvt_pk_bf16(q[2], q[3]); wq.z = cvt_pk_bf16(q[4], q[5]); wq.w = cvt_pk_bf16(q[6], q[7]); *(u32x4*)(tp + cc * 2) = wq; }
                                else if (kind == 3) *(u32x4*)(tp + 256 + cc * 2) = w;
                                else { const float* lbp = side_lb + (kind - 1) * 1024 + hh * 128 + cc; const f32x4 l0 = *(const f32x4*)lbp, l1 = *(const f32x4*)(lbp + 4); f32x4 f0, f1;
#pragma unroll
                                    for (int e = 0; e < 4; ++e) { f0[e] = l0[e] + (1.f - l0[e]) * __builtin_amdgcn_rcpf(1.f + __builtin_amdgcn_exp2f(-1.4426950408889634f * v0[e])); f1[e] = l1[e] + (1.f - l1[e]) * __builtin_amdgcn_rcpf(1.f + __builtin_amdgcn_exp2f(-1.4426950408889634f * v1[e])); }
                                    float* fp = (float*)(tp + 512 * kind) + cc; *(f32x4*)fp = f0; *(f32x4*)(fp + 4) = f1; } }
                            else *(u32x4*)(O2 + (size_t)row * 4096 + (col - 4096)) = w; }
                        else *(u32x4*)(O + (size_t)row * ldc + col) = w; }
                    if (MODE == 3) { if (row < 8192 && col >= 6144) { float* fp = (col < 7168) ? side_k + (size_t)row * 1024 + (col - 6144) : side_v + (size_t)row * 1024 + (col - 7168);
                        *(f32x4*)fp = v0; *(f32x4*)(fp + 4) = v1; } }
                } }
    }
};
template <class Epi, class Sched, bool ALIGN_EPI = false, bool SP2 = false>
__device__ __forceinline__ void gemm_phase(PG8_LAS unsigned char* lds, const Gemm g, const Sched& S, const Epi& E) {
    const int tid = threadIdx.x, wid = __builtin_amdgcn_readfirstlane(tid >> 6), lane = tid & 63, wr = wid >> 2, wc = wid & 3, fr = lane & 15, fq = lane >> 4;
    const int K = g.K, nt = K / BK;
    unsigned voffA[2], voffB[2];
#pragma unroll
    for (int i = 0; i < 2; ++i) { int R, C; stage_rc(tid * 16 + i * 8192, R, C); const int Rb = Epi::PERM ? ((R & ~31) + perm32(R & 31)) : R;
        voffA[i] = (unsigned)(R * K + C) * 2u; voffB[i] = (unsigned)(Rb * K + C) * 2u; }
    const size_t kstep = (size_t)(BK * 2);
    const size_t hstep = (size_t)HALF * K * 2;
    const size_t tstep = 2 * hstep;
    const unsigned ldsw = (unsigned)wid * 1024u;
    const int aoff = lds_byte(wr * 64 + fr, fq * 8), boff = lds_byte(wc * 32 + fr, fq * 8);
#define PG8_SA(b, h) (((b) * 2 + (h)) * HTB)
#define PG8_SB(b, h) ((4 + (b) * 2 + (h)) * HTB)
#define PG8_STAGE(bufoff, gbase, voff) do { _Pragma("unroll") for (int _i = 0; _i < 2; ++_i) \
        __builtin_amdgcn_global_load_lds((const unsigned*)((const char*)(gbase) + (voff)[_i]), (PG8_LAS unsigned*)(lds + (bufoff) + ldsw + _i * 8192), 16, 0, 0); } while (0)
#define PG8_LDA(dst, b, h) do { _Pragma("unroll") for (int m = 0; m < 4; ++m) _Pragma("unroll") for (int k = 0; k < 2; ++k) dst[m][k] = *(const PG8_LAS bf16x8*)(lds + PG8_SA(b, h) + aoff + m * 2048 + k * 1024); } while (0)
#define PG8_LDB(dst, b, h) do { _Pragma("unroll") for (int n = 0; n < 2; ++n) _Pragma("unroll") for (int k = 0; k < 2; ++k) dst[n][k] = *(const PG8_LAS bf16x8*)(lds + PG8_SB(b, h) + boff + n * 2048 + k * 1024); } while (0)
#define PG8_MMA(ai, bj, At, Bt) do { __builtin_amdgcn_s_setprio(1); _Pragma("unroll") for (int m = 0; m < 4; ++m) _Pragma("unroll") for (int n = 0; n < 2; ++n) _Pragma("unroll") for (int k = 0; k < 2; ++k) \
        acc[ai][bj][m][n] = __builtin_amdgcn_mfma_f32_16x16x32_bf16(Bt[n][k], At[m][k], acc[ai][bj][m][n], 0, 0, 0); __builtin_amdgcn_s_setprio(0); } while (0)
#define PG8_WAIT_V(n) asm volatile("s_waitcnt vmcnt(" #n ")" ::: "memory")
#define PG8_WAIT_L(n) asm volatile("s_waitcnt lgkmcnt(" #n ")" ::: "memory")
#define PG8_BAR __builtin_amdgcn_s_barrier()
#define PG8_SCHED __builtin_amdgcn_sched_barrier(0)
    Unit cur, nxt; int ui = 0;
    if (!S.next(0, cur)) return;
    f32x4 acc[2][2][4][2];
#pragma unroll
    for (int a = 0; a < 2; ++a)
#pragma unroll
        for (int b = 0; b < 2; ++b)
#pragma unroll
            for (int m = 0; m < 4; ++m)
#pragma unroll
                for (int n = 0; n < 2; ++n) acc[a][b][m][n] = (f32x4){0.f, 0.f, 0.f, 0.f};
    bf16x8 At[4][2], B0[2][2], B1[2][2];
    const char* cA = (const char*)g.A + (size_t)cur.pm * tstep; const char* cB = (const char*)g.Bt + (size_t)cur.pn * tstep;
    S.a_ready(cur);
    if constexpr (SP2) {
        PG8_STAGE(PG8_SB(0, 0), cB, voffB); PG8_STAGE(PG8_SB(0, 1), cB + hstep, voffB); PG8_STAGE(PG8_SA(0, 0), cA, voffA); PG8_STAGE(PG8_SA(0, 1), cA + hstep, voffA);
        if (wr == 1) PG8_BAR;
        PG8_WAIT_V(2); PG8_BAR;
        PG8_STAGE(PG8_SB(1, 0), cB + kstep, voffB); PG8_STAGE(PG8_SA(1, 0), cA + kstep, voffA); PG8_STAGE(PG8_SB(1, 1), cB + hstep + kstep, voffB);
        PG8_WAIT_V(6); PG8_BAR;
    } else {
        PG8_STAGE(PG8_SB(0, 0), cB, voffB); PG8_STAGE(PG8_SA(0, 0), cA, voffA); PG8_STAGE(PG8_SB(0, 1), cB + hstep, voffB); PG8_STAGE(PG8_SA(0, 1), cA + hstep, voffA);
        if (wr == 1) PG8_BAR;
        PG8_WAIT_V(4); PG8_BAR;
        PG8_STAGE(PG8_SB(1, 0), cB + kstep, voffB); PG8_STAGE(PG8_SA(1, 0), cA + kstep, voffA); PG8_STAGE(PG8_SB(1, 1), cB + hstep + kstep, voffB);
        PG8_WAIT_V(6); PG8_BAR;
    }
    for (;;) {
        const bool has_next = S.next(ui + 1, nxt);
        const char* nA = has_next ? (const char*)g.A + (size_t)nxt.pm * tstep : cA; const char* nB = has_next ? (const char*)g.Bt + (size_t)nxt.pn * tstep : cB;
        for (int t = 0; t < nt; t += 2) {
            const bool last = (t == nt - 2);
            const char* a1 = cA + (size_t)(t + 1) * kstep;
            const char* a2 = last ? nA : cA + (size_t)(t + 2) * kstep; const char* b2 = last ? nB : cB + (size_t)(t + 2) * kstep;
            const char* a3 = a2 + kstep; const char* b3 = b2 + kstep;
            if (last && has_next) S.a_ready(nxt);
            if constexpr (SP2) {
            PG8_LDB(B0, 0, 0); PG8_LDB(B1, 0, 1); PG8_SCHED; PG8_LDA(At, 0, 0); PG8_STAGE(PG8_SA(1, 1), a1 + hstep, voffA);
            PG8_WAIT_V(8); PG8_WAIT_L(0); PG8_BAR; PG8_MMA(0, 0, At, B0); PG8_MMA(0, 1, At, B1); PG8_BAR; PG8_SCHED;
            PG8_LDA(At, 0, 1); PG8_STAGE(PG8_SB(0, 0), b2, voffB); PG8_STAGE(PG8_SB(0, 1), b2 + hstep, voffB); PG8_STAGE(PG8_SA(0, 0), a2, voffA);
            PG8_WAIT_V(8); PG8_WAIT_L(0); PG8_BAR; PG8_MMA(1, 0, At, B0); PG8_MMA(1, 1, At, B1); PG8_BAR; PG8_SCHED;
            PG8_LDB(B0, 1, 0); PG8_LDB(B1, 1, 1); PG8_SCHED; PG8_LDA(At, 1, 0); PG8_STAGE(PG8_SA(0, 1), a2 + hstep, voffA);
            PG8_WAIT_V(8); PG8_WAIT_L(0); PG8_BAR; PG8_MMA(0, 0, At, B0); PG8_MMA(0, 1, At, B1); PG8_BAR; PG8_SCHED;
            PG8_LDA(At, 1, 1); PG8_STAGE(PG8_SB(1, 0), b3, voffB); PG8_STAGE(PG8_SB(1, 1), b3 + hstep, voffB); PG8_STAGE(PG8_SA(1, 0), a3, voffA);
            PG8_WAIT_V(8); PG8_WAIT_L(0); PG8_BAR; PG8_MMA(1, 0, At, B0); PG8_MMA(1, 1, At, B1); PG8_BAR; PG8_SCHED;
            } else {
            PG8_LDB(B0, 0, 0); PG8_SCHED; PG8_LDA(At, 0, 0); PG8_STAGE(PG8_SA(1, 1), a1 + hstep, voffA);
            PG8_WAIT_L(8); PG8_BAR; PG8_WAIT_L(0); PG8_MMA(0, 0, At, B0); PG8_BAR; PG8_SCHED;
            PG8_LDB(B1, 0, 1); PG8_STAGE(PG8_SB(0, 0), b2, voffB);
            PG8_BAR; PG8_WAIT_L(0); PG8_MMA(0, 1, At, B1); PG8_BAR;
            PG8_LDA(At, 0, 1); PG8_STAGE(PG8_SA(0, 0), a2, voffA);
            PG8_BAR; PG8_WAIT_L(0); PG8_MMA(1, 0, At, B0); PG8_BAR; PG8_SCHED;
            PG8_STAGE(PG8_SB(0, 1), b2 + hstep, voffB);
            PG8_WAIT_V(6); PG8_BAR; PG8_MMA(1, 1, At, B1); PG8_BAR;
            PG8_LDB(B0, 1, 0); PG8_SCHED; PG8_LDA(At, 1, 0); PG8_STAGE(PG8_SA(0, 1), a2 + hstep, voffA);
            PG8_WAIT_L(8); PG8_BAR; PG8_WAIT_L(0); PG8_MMA(0, 0, At, B0); PG8_BAR; PG8_SCHED;
            PG8_LDB(B1, 1, 1); PG8_STAGE(PG8_SB(1, 0), b3, voffB);
            PG8_BAR; PG8_WAIT_L(0); PG8_MMA(0, 1, At, B1); PG8_BAR;
            PG8_LDA(At, 1, 1); PG8_STAGE(PG8_SA(1, 0), a3, voffA);
            PG8_BAR; PG8_WAIT_L(0); PG8_MMA(1, 0, At, B0); PG8_BAR; PG8_SCHED;
            PG8_STAGE(PG8_SB(1, 1), b3 + hstep, voffB);
            PG8_WAIT_V(6); PG8_BAR; PG8_MMA(1, 1, At, B1); PG8_BAR;
            }
        }
        if constexpr (ALIGN_EPI) { if (wr == 0) PG8_BAR; }
        if constexpr (!Epi::AFTER_DRAIN) { E(acc, cur, wr, wc, fr, fq); S.done(cur); }
        if (!has_next) break;
#pragma unroll
        for (int a = 0; a < 2; ++a)
#pragma unroll
            for (int b = 0; b < 2; ++b)
#pragma unroll
                for (int m = 0; m < 4; ++m)
#pragma unroll
                    for (int n = 0; n < 2; ++n) acc[a][b][m][n] = (f32x4){0.f, 0.f, 0.f, 0.f};
        cur = nxt; cA = nA; cB = nB; ++ui;
        if constexpr (ALIGN_EPI) { if (wr == 1) PG8_BAR; }
    }
    PG8_WAIT_V(0);
    if constexpr (!ALIGN_EPI) { if (wr == 0) PG8_BAR; }
    PG8_BAR;
    if constexpr (Epi::AFTER_DRAIN) { E.fused(acc, cur, wr, wc, fr, fq, lds, wid, lane); S.done(cur); }
#undef PG8_SA
#undef PG8_SB
#undef PG8_STAGE
#undef PG8_LDA
#undef PG8_LDB
#undef PG8_MMA
#undef PG8_WAIT_V
#undef PG8_WAIT_L
#undef PG8_BAR
#undef PG8_SCHED
}
}
constexpr int DM = 2048, DFF = 8192;
constexpr int CB = 32, CT = 256, LBT = 8, LT = 2048, PAST = 512;
constexpr int MC = CB * CT, ML = LBT * LT, MT = MC + ML;
constexpr int MKV = MT + LBT * PAST;
constexpr int EVEN_IN = 8192, ODD_IN = 1088, ODD_PAD = 1280;
constexpr float EPS = 1e-6f;
constexpr float LOG2E = 1.4426950408889634f;
constexpr size_t O_Y = 0, O_SF = (size_t)MT * DM, O_SB = O_SF + 4194304, O_NK = O_SB + 4194304, O_NV = O_NK + 8388608, O_CKV = O_NV + 8388608, O_KPE = O_CKV + 4194304, O_END = O_KPE + 524288;
constexpr size_t MiB = 1u << 20;
constexpr size_t WS_CTL = 0, CTL_ZERO_BYTES = 256 * 1024;
constexpr size_t WS_MOD = 1 * MiB;
constexpr size_t WS_ROPE = 2 * MiB;
constexpr size_t WS_BIAS = 3 * MiB;
constexpr size_t WS_MODP = 5 * MiB;
constexpr size_t WS_WINE = 19 * MiB, WS_WOUTE = 51 * MiB, WS_W1_0 = 59 * MiB, WS_W2_0 = 91 * MiB, WS_W1_1 = 123 * MiB, WS_W2_1 = 155 * MiB;
constexpr size_t WS_WINO = 187 * MiB, WS_WUQ = 192 * MiB, WS_WUKV = 195 * MiB, WS_WOUTO = 199 * MiB;
constexpr size_t WS_B = 207 * MiB;
constexpr size_t WS_C = 303 * MiB;
constexpr size_t WS_CKVX = WS_C + 144 * MiB;
constexpr size_t WS_D = 687 * MiB;
constexpr size_t WS_D_CQN = WS_D, WS_D_CKVN = WS_D + 24 * MiB, WS_D_KROT = WS_D + 52 * MiB;
constexpr size_t WS_SCAN = WS_C, WS_P2 = WS_C + 288 * MiB;
constexpr size_t WS_LBT = WS_ROPE + 65536;
constexpr size_t WS_END = 783 * MiB;
constexpr int CW_BAR = 4096, CW_Q0 = 8192, CW_Q1 = 8192 + 1024;
constexpr int RING_BYTES = 155648, LDSCTL_OFF = RING_BYTES, MISC_OFF = LDSCTL_OFF + 320, LDS_BYTES = 163840;

#define GAS __attribute__((address_space(1)))
#define LAS __attribute__((address_space(3)))
typedef unsigned short bf16;
typedef unsigned v4u __attribute__((ext_vector_type(4)));
typedef unsigned v2u __attribute__((ext_vector_type(2)));
typedef float f32x4 __attribute__((ext_vector_type(4)));
typedef float f32x16 __attribute__((ext_vector_type(16)));
typedef short bf16x8 __attribute__((ext_vector_type(8)));
typedef short s16x4 __attribute__((ext_vector_type(4)));
typedef GAS unsigned gu32;
#define RLX_AGENT __ATOMIC_RELAXED, __HIP_MEMORY_SCOPE_AGENT
#define LDS_WAIT() asm volatile("s_waitcnt lgkmcnt(0)" ::: "memory")
#define VM_WAIT() asm volatile("s_waitcnt vmcnt(0)" ::: "memory")
__device__ __forceinline__ unsigned f2bf(float f) { unsigned u = __builtin_bit_cast(unsigned, f); return (u + 0x7fffu + ((u >> 16) & 1u)) >> 16; }
__device__ __forceinline__ unsigned pk2(float lo, float hi) { return f2bf(lo) | (f2bf(hi) << 16); }
__device__ __forceinline__ float bf2f(unsigned short b) { return __builtin_bit_cast(float, (unsigned)b << 16); }
__device__ __forceinline__ float bflo(unsigned w) { return __builtin_bit_cast(float, w << 16); }
__device__ __forceinline__ float bfhi(unsigned w) { return __builtin_bit_cast(float, w & 0xffff0000u); }
__device__ __forceinline__ float wave_sum(float v) {
#pragma unroll
    for (int o = 1; o < 64; o <<= 1) v += __shfl_xor(v, o);
    return v;
}
#define XB_TMO      128
#define XB_XCNT(j)  (256  + 64 * (j))
#define XB_XSUB(j)  (1280 + 64 * (j))
#define XB_XGEN(j)  (2304 + 64 * (j))
#define XB_TOP      3328
#define XB_TOPGEN   3392
#define XCD_BAR_WORDS 3456
#define XB_SPIN_CAP (1u << 18)

__device__ __forceinline__ unsigned xb_ld(unsigned* p)              { return __hip_atomic_load(p, __ATOMIC_RELAXED, __HIP_MEMORY_SCOPE_AGENT); }
__device__ __forceinline__ unsigned xb_add(unsigned* p, unsigned v) { return __hip_atomic_fetch_add(p, v, __ATOMIC_RELAXED, __HIP_MEMORY_SCOPE_AGENT); }
__device__ __forceinline__ unsigned xb_xcc_id() { return (unsigned)__builtin_amdgcn_s_getreg((3 << 11) | 20) & 0xFu; }
#define XB_SPIN(cond, bar) do { unsigned _sp = 0; while (cond) { __builtin_amdgcn_s_sleep(1); \
    if ((++_sp & 255u) == 0u) { if (xb_ld(&(bar)[XB_TMO])) break; if (_sp > XB_SPIN_CAP) { atomicAdd(&(bar)[XB_TMO], 1u); break; } } } } while (0)

struct XcdBarrier {
    unsigned* bar; unsigned x;
    volatile LAS unsigned* st;
};

__device__ __forceinline__ XcdBarrier xcd_barrier_post(unsigned* bar, volatile LAS unsigned* st) {
    XcdBarrier b; b.bar = bar; b.x = xb_xcc_id(); b.st = st;
    if (threadIdx.x == 0) (void)xb_add(&bar[XB_XCNT(b.x)], 1u);
    return b;
}
__device__ __forceinline__ void xcd_barrier_complete(unsigned* bar, unsigned x, unsigned& nloc, unsigned& nx) {
    const unsigned G = gridDim.x * gridDim.y * gridDim.z;
    unsigned sum, cnt, mine, sp = 0u;
    for (;;) {
        sum = 0u; cnt = 0u; mine = 0u;
#pragma unroll
        for (unsigned j = 0; j < 16; ++j) { const unsigned c = xb_ld(&bar[XB_XCNT(j)]); sum += c; cnt += (c > 0u) ? 1u : 0u; mine = (j == x) ? c : mine; }
        if (sum == G) break;
        __builtin_amdgcn_s_sleep(1);
        if ((++sp & 255u) == 0u) { if (xb_ld(&bar[XB_TMO])) break; if (sp > XB_SPIN_CAP) { atomicAdd(&bar[XB_TMO], 1u); break; } }
    }
    nloc = mine > 0u ? mine : 1u; nx = cnt > 0u ? cnt : 1u;
}

__device__ __forceinline__ void xcd_barrier(const XcdBarrier& b) {
    asm volatile("s_waitcnt vmcnt(0)" ::: "memory");
    __syncthreads();
    if (threadIdx.x == 0) {
        unsigned* bar = b.bar;
        __builtin_amdgcn_s_waitcnt(0);
        unsigned nloc = b.st[0], nx = b.st[1];
        if (nloc == 0u) { xcd_barrier_complete(bar, b.x, nloc, nx); b.st[0] = nloc; b.st[1] = nx; }
        const unsigned old = xb_add(&bar[XB_XSUB(b.x)], 1u);
        const unsigned gen = old / nloc;
        if (old + 1u == (gen + 1u) * nloc) {
            __builtin_amdgcn_fence(__ATOMIC_RELEASE, "agent");
            asm volatile("s_waitcnt vmcnt(0)" ::: "memory");
            const unsigned og = xb_add(&bar[XB_TOP], 1u);
            const unsigned tg = og / nx;
            if (og + 1u == (tg + 1u) * nx) xb_add(&bar[XB_TOPGEN], 1u);
            else XB_SPIN(xb_ld(&bar[XB_TOPGEN]) == tg, bar);
            __builtin_amdgcn_fence(__ATOMIC_ACQUIRE, "agent");
            xb_add(&bar[XB_XGEN(b.x)], 1u);
            asm volatile("s_waitcnt vmcnt(0)" ::: "memory");
        } else {
            XB_SPIN(xb_ld(&bar[XB_XGEN(b.x)]) == gen, bar);
            __builtin_amdgcn_fence(__ATOMIC_ACQUIRE, "agent");
            asm volatile("s_waitcnt vmcnt(0)" ::: "memory");
        }
    }
    __syncthreads();
}
struct Args { const float* in[27]; float* out; unsigned char* ws; int ph_lo, ph_hi, li, pad; };
enum { I_XP = 0, I_XS, I_SF, I_SB, I_NAK, I_NAV, I_CKV, I_KPE, I_C, I_CCTX, I_ADAW, I_ADAB, I_NG, I_LBF, I_LBB, I_WINE, I_HNG, I_RPB, I_WOUTE, I_WINO, I_QNG, I_WUQ, I_KVNG, I_WUKV, I_WOUTO, I_W1, I_W2 };

__device__ __forceinline__ void p0_transpose_item(const float* W, int K, int N, bf16* WT, LAS float* scr, int item, int lane) {
    const int nblk = N / 32, kb = item / nblk, nb = item % nblk, k0 = 64 * kb, n0 = 32 * nb;
#pragma unroll 8
    for (int i = 0; i < 32; ++i) { const int kk = 2 * i + (lane >> 5); scr[kk * 33 + (lane & 31)] = W[(size_t)(k0 + kk) * N + n0 + (lane & 31)]; }
    LDS_WAIT(); asm volatile("" ::: "memory");
    const int c = lane & 7;
#pragma unroll
    for (int j = 0; j < 4; ++j) { const int n = (lane >> 3) + 8 * j; const LAS float* s = scr + (8 * c) * 33 + n;
        v4u o; o.x = pk2(s[0 * 33], s[1 * 33]); o.y = pk2(s[2 * 33], s[3 * 33]); o.z = pk2(s[4 * 33], s[5 * 33]); o.w = pk2(s[6 * 33], s[7 * 33]);
        *(GAS v4u*)(WT + (size_t)(n0 + n) * K + k0 + 8 * c) = o; }
    LDS_WAIT(); asm volatile("" ::: "memory");
}

__device__ __forceinline__ void phase_prologue(const Args& a, LAS unsigned char* lds, int tid, int lane, int wave, int vcu, int G) {
    const int gw = vcu * 8 + wave, NGW = G * 8;
    unsigned char* ws = a.ws;
    {
        LAS float* scr = (LAS float*)(lds + wave * 16384);
        constexpr int I_A = 32 * 256, I_B = 32 * 64, I_C1 = 32 * 256, I_C2 = 128 * 64, I_D = 32 * 34, I_E = 8 * 96, I_F = 8 * 128, I_G = 32 * 64;
        constexpr int NITEMS = I_A + I_B + 2 * I_C1 + 2 * I_C2 + I_D + I_E + I_F + I_G;
        for (int it = gw; it < NITEMS; it += NGW) {
            int r = it;
            if (r < I_A) { p0_transpose_item(a.in[I_WINE], 2048, 8192, (bf16*)(ws + WS_WINE), scr, r, lane); continue; } r -= I_A;
            if (r < I_B) { p0_transpose_item(a.in[I_WOUTE], 2048, 2048, (bf16*)(ws + WS_WOUTE), scr, r, lane); continue; } r -= I_B;
            if (r < I_C1) { p0_transpose_item(a.in[I_W1], 2048, 8192, (bf16*)(ws + WS_W1_0), scr, r, lane); continue; } r -= I_C1;
            if (r < I_C1) { p0_transpose_item(a.in[I_W1] + (size_t)2048 * 8192, 2048, 8192, (bf16*)(ws + WS_W1_1), scr, r, lane); continue; } r -= I_C1;
            if (r < I_C2) { p0_transpose_item(a.in[I_W2], 8192, 2048, (bf16*)(ws + WS_W2_0), scr, r, lane); continue; } r -= I_C2;
            if (r < I_C2) { p0_transpose_item(a.in[I_W2] + (size_t)2048 * 8192, 8192, 2048, (bf16*)(ws + WS_W2_1), scr, r, lane); continue; } r -= I_C2;
            if (r < I_D) { p0_transpose_item(a.in[I_WINO], 2048, 1088, (bf16*)(ws + WS_WINO), scr, r, lane); continue; } r -= I_D;
            if (r < I_E) { p0_transpose_item(a.in[I_WUQ], 512, 3072, (bf16*)(ws + WS_WUQ), scr, r, lane); continue; } r -= I_E;
            if (r < I_F) { p0_transpose_item(a.in[I_WUKV], 512, 4096, (bf16*)(ws + WS_WUKV), scr, r, lane); continue; } r -= I_F;
            p0_transpose_item(a.in[I_WOUTO], 2048, 2048, (bf16*)(ws + WS_WOUTO), scr, r, lane);
        }
    }
    const size_t gt = (size_t)gw * 64 + lane, NGT = (size_t)NGW * 64;
    { GAS v4u* z = (GAS v4u*)(ws + WS_WINO + (size_t)1088 * 2048 * 2); for (size_t i = gt; i < (size_t)192 * 2048 * 2 / 16; i += NGT) z[i] = (v4u){0u, 0u, 0u, 0u}; }
    { float* bt = (float*)(ws + WS_BIAS); const float* rpb = a.in[I_RPB];
      for (size_t i = gt; i < (size_t)8 * 16 * 64 * 64; i += NGT) { const int kc = (int)(i & 63), qc = (int)((i >> 6) & 63), dr = (int)((i >> 12) & 15), hh = (int)(i >> 16);
          int cs = qc - 8; cs = cs < 0 ? 0 : (cs > 48 ? 48 : cs); const bool ok = kc >= cs && kc < cs + 16; int ci = kc - qc + 15; ci = ci < 0 ? 0 : (ci > 30 ? 30 : ci);
          bt[i] = dr == 15 ? 0.f : (ok ? rpb[(hh * 15 + dr) * 31 + ci] * 11.313708498984761f : -1e30f); } }
    { float* rt = (float*)(ws + WS_ROPE);
      for (size_t i = gt; i < 64 * 32; i += NGT) { const int pos = (int)(i >> 5), j = (int)(i & 31), i16 = j & 15; const float inv = powf(10000.f, -(float)(2 * i16) / 32.f); const float ang = (float)pos * inv;
          rt[i] = j < 16 ? cosf(ang) : sinf(ang); } }
    { const f32x4* sk = (const f32x4*)a.in[I_NAK]; const f32x4* sv = (const f32x4*)a.in[I_NAV]; GAS v2u* dk = (GAS v2u*)(a.out + O_CKV); GAS v2u* dv = (GAS v2u*)(a.out + O_CKV + 2097152);
      for (size_t i = gt; i < (size_t)4194304 / 4; i += NGT) { const f32x4 x = sk[i], y = sv[i]; dk[i] = (v2u){pk2(x.x, x.y), pk2(x.z, x.w)}; dv[i] = (v2u){pk2(y.x, y.y), pk2(y.z, y.w)}; } }
    { float* lt = (float*)(ws + WS_LBT);
      for (size_t i = gt; i < 2048; i += NGT) { const float* lbp = (i < 1024 ? a.in[I_LBF] : a.in[I_LBB]) + (i & 1023); const float x0 = lbp[0], x1 = lbp[1024], x2 = lbp[2048]; const float mx = fmaxf(x0, fmaxf(x1, x2));
          const float e0 = __expf(x0 - mx), e1 = __expf(x1 - mx), e2 = __expf(x2 - mx); lt[i] = e0 / (e0 + e1 + e2); } }
    __syncthreads();
    {
        LAS float* S = (LAS float*)lds;
        for (int i = tid; i < 9 * 2048; i += 512) { const int r = i >> 11, k = i & 2047; const float x = r == 0 ? a.in[I_CCTX][k] : a.in[I_C][(r - 1) * 2048 + k]; S[k * 12 + r] = x / (1.f + __expf(-x)); }
        __syncthreads();
        float* modp = (float*)(ws + WS_MODP);
        for (int task = gw; task < 2 * 48 * 16; task += NGW) {
            const int l = task / 768, rem = task % 768, cg = rem >> 4, ks = rem & 15, col = cg * 256 + lane * 4;
            const float* W = a.in[I_ADAW] + ((size_t)l * 2048 + ks * 128) * 12288 + col;
            f32x4 acc[9];
#pragma unroll
            for (int r = 0; r < 9; ++r) acc[r] = (f32x4){0.f, 0.f, 0.f, 0.f};
#pragma unroll 4
            for (int kk = 0; kk < 128; ++kk) { const f32x4 w = *(const f32x4*)(W + (size_t)kk * 12288); const LAS f32x4* sp = (const LAS f32x4*)(S + (ks * 128 + kk) * 12);
                const f32x4 s0 = sp[0], s1 = sp[1], s2 = sp[2];
                acc[0] += w * s0.x; acc[1] += w * s0.y; acc[2] += w * s0.z; acc[3] += w * s0.w; acc[4] += w * s1.x; acc[5] += w * s1.y; acc[6] += w * s1.z; acc[7] += w * s1.w; acc[8] += w * s2.x; }
#pragma unroll
            for (int r = 0; r < 9; ++r) *(f32x4*)(modp + ((size_t)(l * 16 + ks) * 9 + r) * 12288 + col) = acc[r];
        }
    }
}

__device__ __forceinline__ void phase_mod_reduce(const Args& a, int gw, int lane, int NGW) {
    const float* modp = (const float*)(a.ws + WS_MODP); float* mod = (float*)(a.ws + WS_MOD);
    for (size_t i = (size_t)gw * 64 + lane; i < (size_t)2 * 9 * 12288; i += (size_t)NGW * 64) { const int l = (int)(i / 110592), rc = (int)(i % 110592), col = rc % 12288;
        float s = a.in[I_ADAB][l * 12288 + col];
#pragma unroll
        for (int ks = 0; ks < 16; ++ks) s += modp[(size_t)(l * 16 + ks) * 110592 + rc];
        mod[i] = s; }
}

template <bool POST, bool PRE>
__device__ __forceinline__ void row_pass(const float* xc, const float* xs, const bf16* y, float* xdst, bf16* hdst, const float* gpost, const float* gate0, const float* gpre, const float* shift0, const float* scale0,
                                         int gw, int lane, int NGW) {
    for (int m = gw; m < MT; m += NGW) {
        const int grp = m < MC ? 0 : 1 + ((m - MC) >> 11);
        const float* xr = (m < MC) ? xc + (size_t)m * DM : xs + (size_t)(m - MC) * DM;
        f32x4 v[8];
#pragma unroll
        for (int j = 0; j < 8; ++j) v[j] = *(const f32x4*)(xr + 4 * lane + 256 * j);
        if (POST) {
            const bf16* yr = y + (size_t)m * DM; f32x4 t[8]; float ss = 0.f;
#pragma unroll
            for (int j = 0; j < 8; ++j) { const v2u w = *(const v2u*)(yr + 4 * lane + 256 * j); t[j] = (f32x4){bflo(w.x), bfhi(w.x), bflo(w.y), bfhi(w.y)}; ss += (t[j].x * t[j].x + t[j].y * t[j].y) + (t[j].z * t[j].z + t[j].w * t[j].w); }
            const float rs = rsqrtf(wave_sum(ss) * (1.f / DM) + EPS);
            const float* gt = gate0 + (size_t)grp * 12288;
#pragma unroll
            for (int j = 0; j < 8; ++j) { const f32x4 g = *(const f32x4*)(gpost + 4 * lane + 256 * j), ga = *(const f32x4*)(gt + 4 * lane + 256 * j); v[j] = v[j] + ga * (t[j] * rs * g); }
            float* xo = xdst + (size_t)m * DM;
#pragma unroll
            for (int j = 0; j < 8; ++j) *(f32x4*)(xo + 4 * lane + 256 * j) = v[j];
        }
        if (PRE) {
            float ss = 0.f;
#pragma unroll
            for (int j = 0; j < 8; ++j) ss += (v[j].x * v[j].x + v[j].y * v[j].y) + (v[j].z * v[j].z + v[j].w * v[j].w);
            const float rs = rsqrtf(wave_sum(ss) * (1.f / DM) + EPS);
            const float* sh = shift0 + (size_t)grp * 12288; const float* sc = scale0 + (size_t)grp * 12288; bf16* ho = hdst + (size_t)m * DM;
#pragma unroll
            for (int j = 0; j < 8; ++j) { const f32x4 g = *(const f32x4*)(gpre + 4 * lane + 256 * j), s1 = *(const f32x4*)(sc + 4 * lane + 256 * j), s0 = *(const f32x4*)(sh + 4 * lane + 256 * j);
                const f32x4 o = (v[j] * rs * g) * (s1 + 1.f) + s0; *(v2u*)(ho + 4 * lane + 256 * j) = (v2u){pk2(o.x, o.y), pk2(o.z, o.w)}; }
        }
    }
}

__device__ __forceinline__ void phase_hgrn_combine(const Args& a, int gw, int lane, int NGW) {
    const float* ofw = a.out; const float* obw = a.out + (size_t)MT * 1024; const bf16* proj = (const bf16*)(a.ws + WS_P2); bf16* ob = (bf16*)(a.ws + WS_B); const float* hng = a.in[I_HNG];
    const int c0 = lane * 16;
    for (int m = gw; m < MT; m += NGW) {
        f32x4 s[4]; float ss = 0.f;
#pragma unroll
        for (int j = 0; j < 4; ++j) { s[j] = *(const f32x4*)(ofw + (size_t)m * 1024 + c0 + 4 * j) + *(const f32x4*)(obw + (size_t)m * 1024 + c0 + 4 * j); ss += (s[j].x * s[j].x + s[j].y * s[j].y) + (s[j].z * s[j].z + s[j].w * s[j].w); }
        ss += __shfl_xor(ss, 1); ss += __shfl_xor(ss, 2); ss += __shfl_xor(ss, 4);
        const float rs = rsqrtf(ss * (1.f / 128.f) + EPS);
        const v4u g0 = *(const v4u*)(proj + (size_t)m * 4096 + c0), g1 = *(const v4u*)(proj + (size_t)m * 4096 + c0 + 8);
        float gv[16] = {bflo(g0.x), bfhi(g0.x), bflo(g0.y), bfhi(g0.y), bflo(g0.z), bfhi(g0.z), bflo(g0.w), bfhi(g0.w), bflo(g1.x), bfhi(g1.x), bflo(g1.y), bfhi(g1.y), bflo(g1.z), bfhi(g1.z), bflo(g1.w), bfhi(g1.w)};
        float o[16];
#pragma unroll
        for (int j = 0; j < 4; ++j) { const f32x4 gn = *(const f32x4*)(hng + (c0 & 127) + 4 * j);
#pragma unroll
            for (int e = 0; e < 4; ++e) { const float ga = gv[4 * j + e]; o[4 * j + e] = s[j][e] * rs * gn[e] * (ga / (1.f + __expf(-ga))); } }
        v4u w0 = {pk2(o[0], o[1]), pk2(o[2], o[3]), pk2(o[4], o[5]), pk2(o[6], o[7])}, w1 = {pk2(o[8], o[9]), pk2(o[10], o[11]), pk2(o[12], o[13]), pk2(o[14], o[15])};
        *(v4u*)(ob + (size_t)m * 2048 + c0) = w0; *(v4u*)(ob + (size_t)m * 2048 + c0 + 8) = w1;
    }
}

__device__ __forceinline__ void phase_mla_rows(const Args& a, int gw, int lane, int NGW) {
    const float* cqkv = (const float*)(a.ws + WS_C); bf16* cqn = (bf16*)(a.ws + WS_D_CQN); bf16* ckvn = (bf16*)(a.ws + WS_D_CKVN); bf16* krot = (bf16*)(a.ws + WS_D_KROT); const float* rope = (const float*)(a.ws + WS_ROPE);
    const f32x4 gq0 = *(const f32x4*)(a.in[I_QNG] + lane * 8), gq1 = *(const f32x4*)(a.in[I_QNG] + lane * 8 + 4), gk0 = *(const f32x4*)(a.in[I_KVNG] + lane * 8), gk1 = *(const f32x4*)(a.in[I_KVNG] + lane * 8 + 4);
    for (int m = gw; m < MT; m += NGW) {
        const float* r = cqkv + (size_t)m * ODD_PAD;
        { const f32x4 x0 = *(const f32x4*)(r + lane * 8), x1 = *(const f32x4*)(r + lane * 8 + 4);
          const float ss = (x0.x * x0.x + x0.y * x0.y) + (x0.z * x0.z + x0.w * x0.w) + (x1.x * x1.x + x1.y * x1.y) + (x1.z * x1.z + x1.w * x1.w);
          const float rs = rsqrtf(wave_sum(ss) * (1.f / 512.f) + EPS); const f32x4 o0 = x0 * rs * gq0, o1 = x1 * rs * gq1;
          *(v4u*)(cqn + (size_t)m * 512 + lane * 8) = (v4u){pk2(o0.x, o0.y), pk2(o0.z, o0.w), pk2(o1.x, o1.y), pk2(o1.z, o1.w)}; }
        { const f32x4 x0 = *(const f32x4*)(r + 512 + lane * 8), x1 = *(const f32x4*)(r + 512 + lane * 8 + 4);
          const float ss = (x0.x * x0.x + x0.y * x0.y) + (x0.z * x0.z + x0.w * x0.w) + (x1.x * x1.x + x1.y * x1.y) + (x1.z * x1.z + x1.w * x1.w);
          const float rs = rsqrtf(wave_sum(ss) * (1.f / 512.f) + EPS); const f32x4 o0 = x0 * rs * gk0, o1 = x1 * rs * gk1;
          *(v4u*)(ckvn + (size_t)m * 512 + lane * 8) = (v4u){pk2(o0.x, o0.y), pk2(o0.z, o0.w), pk2(o1.x, o1.y), pk2(o1.z, o1.w)};
          if (m < MC) { float* op = a.out + O_CKV + (size_t)m * 512 + lane * 8; *(f32x4*)op = o0; *(f32x4*)(op + 4) = o1; } }
        { const float x = r[1024 + lane];
          if (m < MC) { a.out[O_KPE + (size_t)m * 64 + lane] = x; krot[(size_t)m * 64 + lane] = (bf16)f2bf(x); }
          else { const int pos = (m - MC) & 2047, p = (lane >> 5) ? (pos & 63) : (pos >> 6), j = lane & 31, i16 = j & 15; const float c = rope[p * 32 + i16], s = rope[p * 32 + 16 + i16];
              const float pr = __shfl_xor(x, 16); const float yv = j < 16 ? x * c - pr * s : x * c + pr * s; krot[(size_t)m * 64 + lane] = (bf16)f2bf(yv); } }
    }
    for (int i = gw; i < LBT * PAST; i += NGW) {
        const f32x4 x0 = *(const f32x4*)(a.in[I_CKV] + (size_t)i * 512 + lane * 8), x1 = *(const f32x4*)(a.in[I_CKV] + (size_t)i * 512 + lane * 8 + 4);
        *(v4u*)(ckvn + (size_t)(MT + i) * 512 + lane * 8) = (v4u){pk2(x0.x, x0.y), pk2(x0.z, x0.w), pk2(x1.x, x1.y), pk2(x1.z, x1.w)};
        krot[(size_t)(MT + i) * 64 + lane] = (bf16)f2bf(a.in[I_KPE][(size_t)i * 64 + lane]);
    }
}
namespace hg {
#define KSWZ(row, colB) ((row) * 272 + (colB))
__device__ __forceinline__ int tsw(int row, int sB) { return row * 80 + sB; }
__device__ __forceinline__ int crow(int r, int hi) { return (r & 3) + 8 * (r >> 2) + 4 * hi; }
__device__ __forceinline__ unsigned cvtpk(float lo, float hi) { unsigned r; asm volatile("v_cvt_pk_bf16_f32 %0, %1, %2" : "=v"(r) : "v"(lo), "v"(hi)); return r; }
constexpr int B_QT = 0, B_KT = 8704, B_KTT = 17408, B_VT = 27648, B_SZ = 37888;

__device__ __forceinline__ void hgrn_item(LAS unsigned char* lds, const Args& a, int type, int item, int tid) {
    asm volatile("" : "+v"(tid));
    const int wid = __builtin_amdgcn_readfirstlane(tid >> 6), lane = tid & 63, r32 = lane & 31, hi = lane >> 5;
    const int b = item >> 4, h = (item >> 1) & 7, dir = item & 1;
    const int T = type ? LT : CT, mbase = type ? MC + b * LT : b * CT, NC = T / 32;
    LAS float* Dl0 = (LAS float*)(lds + LDSCTL_OFF + 1024);
    __syncthreads();
    if (wid >= 4) {
        const unsigned char* hgb = (const unsigned char*)(a.ws + WS_SCAN) + ((size_t)mbase * 8 + (size_t)h * T) * 1536;
        const int fo = dir ? 1024 : 512;
        const int t256 = tid & 255, k = t256 & 127, th = __builtin_amdgcn_readfirstlane(t256 >> 7);
        unsigned rqA[16], rqB[16]; float rfLA[16], rfHA[16], rfLB[16], rfHB[16]; v4u rvA[2], rvB[2];
        const int vs = t256 & 31, vc = (t256 >> 5) * 8;
#define HLOAD(c_, rfL, rfH, rq, rv) do { \
        _Pragma("unroll") for (int i_ = 0; i_ < 16; ++i_) { const int p_ = (c_) * 32 + i_; const int t_ = dir ? T - 1 - p_ : p_; const int t2_ = dir ? t_ - 16 * th : t_ + 16 * th; \
            rfL[i_] = *(const float*)(hgb + t_ * 1536 + fo + 4 * k); rfH[i_] = *(const float*)(hgb + t2_ * 1536 + fo + 4 * k); rq[i_] = *(const unsigned short*)(hgb + t2_ * 1536 + 2 * k); } \
        { const int p_ = (c_) * 32 + vs; const int t_ = dir ? T - 1 - p_ : p_; const unsigned char* rp_ = hgb + t_ * 1536 + 256 + 2 * vc; rv[0] = *(const v4u*)rp_; rv[1] = *(const v4u*)(rp_ + 128); } } while (0)
#define HPREP(bufi_, rfL, rfH, rq, rv) do { LAS unsigned char* B_ = lds + (bufi_) * B_SZ; float cp_ = 1.f; \
        if (th) { _Pragma("unroll") for (int i_ = 0; i_ < 16; ++i_) cp_ *= rfL[i_]; } \
        unsigned kw_[8]; unsigned klo_ = 0u; \
        _Pragma("unroll") for (int i_ = 0; i_ < 16; ++i_) { const int s_ = 16 * th + i_; const float f_ = rfH[i_]; cp_ *= f_; const float cc_ = fmaxf(cp_, 1e-30f); \
            const float qt_ = bf2f((unsigned short)rq[i_]) * cc_, kt_ = (1.f - f_) * __builtin_amdgcn_rcpf(cc_); const unsigned w_ = cvtpk(qt_, kt_); \
            *(LAS unsigned short*)(B_ + B_QT + KSWZ(s_, 2 * k)) = (unsigned short)(w_ & 0xffffu); *(LAS unsigned short*)(B_ + B_KT + KSWZ(s_, 2 * k)) = (unsigned short)(w_ >> 16); \
            if (i_ & 1) kw_[i_ >> 1] = klo_ | (w_ & 0xffff0000u); else klo_ = w_ >> 16; } \
        *(LAS v4u*)(B_ + B_KTT + tsw(k, 32 * th)) = (v4u){kw_[0], kw_[1], kw_[2], kw_[3]}; *(LAS v4u*)(B_ + B_KTT + tsw(k, 32 * th + 16)) = (v4u){kw_[4], kw_[5], kw_[6], kw_[7]}; \
        if (th) Dl0[(bufi_) * 128 + k] = fmaxf(cp_, 1e-30f); \
        _Pragma("unroll") for (int ps_ = 0; ps_ < 2; ++ps_) { const v4u x_ = rv[ps_]; const int c_ = vc + 64 * ps_; \
            *(LAS unsigned short*)(B_ + B_VT + tsw(c_ + 0, 2 * vs)) = (unsigned short)(x_.x & 0xffffu); *(LAS unsigned short*)(B_ + B_VT + tsw(c_ + 1, 2 * vs)) = (unsigned short)(x_.x >> 16); \
            *(LAS unsigned short*)(B_ + B_VT + tsw(c_ + 2, 2 * vs)) = (unsigned short)(x_.y & 0xffffu); *(LAS unsigned short*)(B_ + B_VT + tsw(c_ + 3, 2 * vs)) = (unsigned short)(x_.y >> 16); \
            *(LAS unsigned short*)(B_ + B_VT + tsw(c_ + 4, 2 * vs)) = (unsigned short)(x_.z & 0xffffu); *(LAS unsigned short*)(B_ + B_VT + tsw(c_ + 5, 2 * vs)) = (unsigned short)(x_.z >> 16); \
            *(LAS unsigned short*)(B_ + B_VT + tsw(c_ + 6, 2 * vs)) = (unsigned short)(x_.w & 0xffffu); *(LAS unsigned short*)(B_ + B_VT + tsw(c_ + 7, 2 * vs)) = (unsigned short)(x_.w >> 16); } } while (0)
        HLOAD(0, rfLA, rfHA, rqA, rvA); HLOAD(1, rfLB, rfHB, rqB, rvB); HPREP(0, rfLA, rfHA, rqA, rvA); HLOAD(2, rfLA, rfHA, rqA, rvA);
        __syncthreads();
        for (int n = 0; n < NC; n += 2) {
            HPREP(1, rfLB, rfHB, rqB, rvB); { const int c3 = n + 3 < NC ? n + 3 : NC - 1; HLOAD(c3, rfLB, rfHB, rqB, rvB); }
            __syncthreads();
            HPREP(0, rfLA, rfHA, rqA, rvA); { const int c4 = n + 4 < NC ? n + 4 : NC - 1; HLOAD(c4, rfLA, rfHA, rqA, rvA); }
            __syncthreads();
        }
#undef HLOAD
#undef HPREP
    } else {
        const int w4 = wid;
        f32x16 S[4];
        if (type) { const float* sp = (dir ? a.in[I_SB] : a.in[I_SF]) + (size_t)(b * 8 + h) * 16384 + 32 * w4 + r32;
#pragma unroll
            for (int kt = 0; kt < 4; ++kt)
#pragma unroll
                for (int r = 0; r < 16; ++r) S[kt][r] = sp[(32 * kt + crow(r, hi)) * 128]; }
        else {
#pragma unroll
            for (int kt = 0; kt < 4; ++kt) S[kt] = (f32x16){}; }
        float* odir = a.out + (dir ? (size_t)MT * 1024 : 0) + h * 128 + 32 * w4 + r32;
        __syncthreads();
        for (int n = 0; n < NC; ++n) {
            const LAS unsigned char* Bf = lds + (n & 1) * B_SZ; const LAS float* Dl = Dl0 + (n & 1) * 128;
            f32x16 O = {};
            { bf16x8 qa[8];
#pragma unroll
              for (int i = 0; i < 8; ++i) { const int cb = (32 * (i >> 1) + 16 * (i & 1)) * 2 + 8 * hi;
                  const s16x4 q0 = *(const LAS s16x4*)(Bf + B_QT + KSWZ(r32, cb)), q1 = *(const LAS s16x4*)(Bf + B_QT + KSWZ(r32, cb + 16));
                  qa[i] = (bf16x8){q0[0], q0[1], q0[2], q0[3], q1[0], q1[1], q1[2], q1[3]}; }
#pragma unroll
              for (int i = 0; i < 8; ++i) { const int kt = i >> 1, st = i & 1;
                  v4u w; w.x = cvtpk(S[kt][8 * st + 0], S[kt][8 * st + 1]); w.y = cvtpk(S[kt][8 * st + 2], S[kt][8 * st + 3]); w.z = cvtpk(S[kt][8 * st + 4], S[kt][8 * st + 5]); w.w = cvtpk(S[kt][8 * st + 6], S[kt][8 * st + 7]);
                  O = __builtin_amdgcn_mfma_f32_32x32x16_bf16(qa[i], __builtin_bit_cast(bf16x8, w), O, 0, 0, 0); } }
            f32x16 X = {};
            { bf16x8 ka[8], qb[8];
#pragma unroll
              for (int d0 = 0; d0 < 8; ++d0) { const int cb = (d0 * 16 + hi * 8) * 2; ka[d0] = *(const LAS bf16x8*)(Bf + B_KT + KSWZ(r32, cb)); qb[d0] = *(const LAS bf16x8*)(Bf + B_QT + KSWZ(r32, cb)); }
#pragma unroll
              for (int d0 = 0; d0 < 8; ++d0) X = __builtin_amdgcn_mfma_f32_32x32x16_bf16(ka[d0], qb[d0], X, 0, 0, 0); }
            bf16x8 vperm[2], vnat[2], ktt[8]; f32x4 dv[16];
#pragma unroll
            for (int st = 0; st < 2; ++st) { const int vrow = 32 * w4 + r32;
                const s16x4 v0 = *(const LAS s16x4*)(Bf + B_VT + tsw(vrow, 32 * st + 8 * hi)), v1 = *(const LAS s16x4*)(Bf + B_VT + tsw(vrow, 32 * st + 8 * hi + 16));
                vperm[st] = (bf16x8){v0[0], v0[1], v0[2], v0[3], v1[0], v1[1], v1[2], v1[3]};
                vnat[st] = *(const LAS bf16x8*)(Bf + B_VT + tsw(vrow, 32 * st + 16 * hi)); }
#pragma unroll
            for (int i = 0; i < 8; ++i) ktt[i] = *(const LAS bf16x8*)(Bf + B_KTT + tsw(32 * (i & 3) + r32, 32 * (i >> 2) + 16 * hi));
#pragma unroll
            for (int i = 0; i < 16; ++i) dv[i] = *(const LAS f32x4*)(Dl + 32 * (i >> 2) + 8 * (i & 3) + 4 * hi);
#pragma unroll
            for (int r = 0; r < 16; ++r) X[r] = (crow(r, hi) <= r32) ? X[r] : 0.f;
#pragma unroll
            for (int st = 0; st < 2; ++st) {
                v4u w; w.x = cvtpk(X[8 * st + 0], X[8 * st + 1]); w.y = cvtpk(X[8 * st + 2], X[8 * st + 3]); w.z = cvtpk(X[8 * st + 4], X[8 * st + 5]); w.w = cvtpk(X[8 * st + 6], X[8 * st + 7]);
                O = __builtin_amdgcn_mfma_f32_32x32x16_bf16(__builtin_bit_cast(bf16x8, w), vperm[st], O, 0, 0, 0);
            }
#pragma unroll
            for (int st = 0; st < 2; ++st)
#pragma unroll
                for (int kt = 0; kt < 4; ++kt) S[kt] = __builtin_amdgcn_mfma_f32_32x32x16_bf16(ktt[st * 4 + kt], vnat[st], S[kt], 0, 0, 0);
#pragma unroll
            for (int r = 0; r < 16; ++r) { const int p = n * 32 + crow(r, hi), t = dir ? T - 1 - p : p; odir[(size_t)(mbase + t) * 1024] = O[r]; }
#pragma unroll
            for (int kt = 0; kt < 4; ++kt)
#pragma unroll
                for (int g = 0; g < 4; ++g) { const f32x4 x = dv[kt * 4 + g]; S[kt][4 * g] *= x.x; S[kt][4 * g + 1] *= x.y; S[kt][4 * g + 2] *= x.z; S[kt][4 * g + 3] *= x.w; }
            __syncthreads();
        }
        if (!type) { float* sp = a.out + (dir ? O_SB : O_SF) + (size_t)(b * 8 + h) * 16384 + 32 * w4 + r32;
#pragma unroll
            for (int kt = 0; kt < 4; ++kt)
#pragma unroll
                for (int r = 0; r < 16; ++r) sp[(32 * kt + crow(r, hi)) * 128] = S[kt][r]; }
    }
}
#undef KSWZ
}

namespace att {
#define KSWZ(row, colB) ((row) * 256 + ((colB) ^ (((row) & 7) << 4)))
#define RSWZ(row, colB) ((row) * 128 + ((colB) ^ (((row) & 7) << 4)))
#define SBAR() __builtin_amdgcn_sched_barrier(0)
constexpr int L_V = 0, L_K = 32768, L_R = 65536, L_WS = 81920, L_QR = 83968;
constexpr float THRL = 11.5f;
__device__ __forceinline__ int crow(int r, int hi) { return (r & 3) + 8 * (r >> 2) + 4 * hi; }
__device__ __forceinline__ unsigned cvtpk(float lo, float hi) { unsigned r; asm volatile("v_cvt_pk_bf16_f32 %0, %1, %2" : "=v"(r) : "v"(lo), "v"(hi)); return r; }
__device__ __forceinline__ int v_st(int k, int c) { const int kk = (k & ~0xC) | ((k & 4) << 1) | ((k & 8) >> 1); return ((kk >> 3) * 4 + (c >> 5)) * 512 + ((kk & 7) * 32 + (c & 31)) * 2; }
__device__ __forceinline__ int v_rd_base(int lane) { return ((lane & 3) << 3) | (((lane >> 2) & 3) << 6) | (((lane >> 4) & 1) << 5) | (((lane >> 5) & 1) << 8); }
constexpr int v_rd_off(int d0, int ks, int half) { return d0 * 512 + ks * 4096 + half * 2048; }
template <int OFF> __device__ __forceinline__ s16x4 tr_read(int vb) { s16x4 r; asm volatile("ds_read_b64_tr_b16 %0, %1 offset:%2" : "=&v"(r) : "v"(vb), "i"(OFF) : "memory"); return r; }
template <int D0> __device__ __forceinline__ void pv_one(f32x16& od, int vb, bf16x8 pa0, bf16x8 pa1, bf16x8 pa2, bf16x8 pa3) {
    const s16x4 l0 = tr_read<v_rd_off(D0, 0, 0)>(vb), h0 = tr_read<v_rd_off(D0, 0, 1)>(vb), l1 = tr_read<v_rd_off(D0, 1, 0)>(vb), h1 = tr_read<v_rd_off(D0, 1, 1)>(vb);
    const s16x4 l2 = tr_read<v_rd_off(D0, 2, 0)>(vb), h2 = tr_read<v_rd_off(D0, 2, 1)>(vb), l3 = tr_read<v_rd_off(D0, 3, 0)>(vb), h3 = tr_read<v_rd_off(D0, 3, 1)>(vb);
    asm volatile("s_waitcnt lgkmcnt(0)" ::: "memory"); SBAR();
#define PK(L, H) (bf16x8){L[0], L[1], L[2], L[3], H[0], H[1], H[2], H[3]}
    od = __builtin_amdgcn_mfma_f32_32x32x16_bf16(pa0, PK(l0, h0), od, 0, 0, 0);
    od = __builtin_amdgcn_mfma_f32_32x32x16_bf16(pa1, PK(l1, h1), od, 0, 0, 0);
    od = __builtin_amdgcn_mfma_f32_32x32x16_bf16(pa2, PK(l2, h2), od, 0, 0, 0);
    od = __builtin_amdgcn_mfma_f32_32x32x16_bf16(pa3, PK(l3, h3), od, 0, 0, 0);
#undef PK
}
struct Seg { const bf16* K; const bf16* V; const bf16* R; int ldk; int nt; };
struct Unit {
    const bf16* Q; int ldq; bf16* O; int ldo; Seg s0, s1;
    const float* rope; int pos0;
    const float* bias; int r0, rs;
    float C;
};
__device__ __forceinline__ bf16x8 ld8(const bf16* p) { return *(const bf16x8*)p; }

template <int DQK, bool NA>
__device__ __forceinline__ void attn_unit(LAS unsigned char* lds, const Unit& U, int tid) {
    asm volatile("" : "+v"(tid));
    const int wid = __builtin_amdgcn_readfirstlane(tid >> 6), lane = tid & 63, r32 = lane & 31, hi = lane >> 5;
    LAS float* wsl = (LAS float*)(lds + L_WS) + wid * 64; LAS float* li_l = wsl; LAS float* al_l = wsl + 32;
    float m_reg = -1e30f, l_reg = 0.f; f32x16 o[4] = {}; bf16x8 qr[8];
    const bf16* Qw = U.Q + (size_t)(wid * 32 + r32) * U.ldq + hi * 8;
#pragma unroll
    for (int d0 = 0; d0 < 8; ++d0) qr[d0] = ld8(Qw + d0 * 16);
    if constexpr (DQK == 192) {
        bf16x8 e0 = ld8(Qw + 128), e1 = ld8(Qw + 144), e2 = ld8(Qw + 160), e3 = ld8(Qw + 176);
        LAS unsigned char* qrl = lds + L_QR + wid * 8192 + lane * 16;
        *(LAS bf16x8*)(qrl + 4096) = e0; *(LAS bf16x8*)(qrl + 5120) = e1; *(LAS bf16x8*)(qrl + 6144) = e2; *(LAS bf16x8*)(qrl + 7168) = e3;
        if (U.rope) { const int pos = U.pos0 + wid * 32 + r32; const float* tr = U.rope + (pos >> 6) * 32 + hi * 8; const float* tc = U.rope + (pos & 63) * 32 + hi * 8;
            unsigned short a0[8], a1[8], a2[8], a3[8];
#pragma unroll
            for (int j = 0; j < 8; ++j) { float c = tr[j], s = tr[16 + j]; float x1 = bf2f((unsigned short)e0[j]), x2 = bf2f((unsigned short)e1[j]); a0[j] = (unsigned short)f2bf(x1 * c - x2 * s); a1[j] = (unsigned short)f2bf(x2 * c + x1 * s);
                c = tc[j]; s = tc[16 + j]; x1 = bf2f((unsigned short)e2[j]); x2 = bf2f((unsigned short)e3[j]); a2[j] = (unsigned short)f2bf(x1 * c - x2 * s); a3[j] = (unsigned short)f2bf(x2 * c + x1 * s); }
#pragma unroll
            for (int j = 0; j < 8; ++j) { e0[j] = (short)a0[j]; e1[j] = (short)a1[j]; e2[j] = (short)a2[j]; e3[j] = (short)a3[j]; } }
        *(LAS bf16x8*)(qrl) = e0; *(LAS bf16x8*)(qrl + 1024) = e1; *(LAS bf16x8*)(qrl + 2048) = e2; *(LAS bf16x8*)(qrl + 3072) = e3;
    }
    const int sr = tid >> 4, sc = (tid & 15) * 8, vst0 = v_st(sr, sc), vst1 = v_st(32 + sr, sc), rr = tid >> 3, rc = (tid & 7) * 8;
    const int vb0 = (int)(unsigned)(uintptr_t)(lds + L_V) + v_rd_base(lane);
    const int nt0 = U.s0.nt, NT = U.s0.nt + U.s1.nt;
    bf16x8 sv0, sv1, sk0, sk1, srp;
#define SLOAD(j_) do { const bool f_ = (j_) < nt0; const bf16* K_ = f_ ? U.s0.K : U.s1.K; const bf16* V_ = f_ ? U.s0.V : U.s1.V; const int ld_ = f_ ? U.s0.ldk : U.s1.ldk; const int k0_ = (f_ ? (j_) : (j_) - nt0) * 64; \
        const unsigned e0_ = (unsigned)((k0_ + sr) * ld_ + sc), e1_ = e0_ + 32u * (unsigned)ld_; \
        sv0 = ld8(V_ + e0_); sv1 = ld8(V_ + e1_); sk0 = ld8(K_ + e0_); sk1 = ld8(K_ + e1_); \
        if constexpr (DQK == 192) { const bf16* R_ = f_ ? U.s0.R : U.s1.R; srp = ld8(R_ + (unsigned)((k0_ + rr) * 64 + rc)); } } while (0)
#define SWRITE(b_) do { *(LAS bf16x8*)(lds + L_V + (b_) * 16384 + vst0) = sv0; *(LAS bf16x8*)(lds + L_V + (b_) * 16384 + vst1) = sv1; \
        *(LAS bf16x8*)(lds + L_K + (b_) * 16384 + KSWZ(sr, sc * 2)) = sk0; *(LAS bf16x8*)(lds + L_K + (b_) * 16384 + KSWZ(32 + sr, sc * 2)) = sk1; \
        if constexpr (DQK == 192) *(LAS bf16x8*)(lds + L_R + (b_) * 8192 + RSWZ(rr, rc * 2)) = srp; } while (0)
    SLOAD(0); VM_WAIT(); SWRITE(0); __syncthreads();
    const float C = U.C;
    for (int j = 0; j < NT; ++j) {
        const int b = j & 1;
        bool valid = true; int dr = 15; const bool lat = NA && j < nt0;
        if (lat) { const int kr = U.rs + j, qrow = U.r0 + (wid >> 1); int w0 = qrow - 4; w0 = w0 < 0 ? 0 : (w0 > 24 ? 24 : w0); valid = kr >= w0 && kr < w0 + 8; dr = valid ? kr - qrow + 7 : 15; }
        f32x16 p0 = {}, p1 = {};
        if constexpr (NA) {
            const float* bp = U.bias + (unsigned)((dr * 64 + 32 * (wid & 1) + r32) * 64 + 4 * hi);
#pragma unroll
            for (int g = 0; g < 4; ++g) { const f32x4 x = *(const f32x4*)(bp + 8 * g), y = *(const f32x4*)(bp + 32 + 8 * g);
                p0[4 * g] = x.x; p0[4 * g + 1] = x.y; p0[4 * g + 2] = x.z; p0[4 * g + 3] = x.w; p1[4 * g] = y.x; p1[4 * g + 1] = y.y; p1[4 * g + 2] = y.z; p1[4 * g + 3] = y.w; } }
        { const int jn = j + 1 < NT ? j + 1 : NT - 1; SLOAD(jn); }
        if (valid) {
            { const LAS unsigned char* Ks = lds + L_K + b * 16384;
#pragma unroll
              for (int d0 = 0; d0 < 8; ++d0) { const int cb = (d0 * 16 + hi * 8) * 2;
                  const bf16x8 b0 = *(const LAS bf16x8*)(Ks + KSWZ(r32, cb)), b1 = *(const LAS bf16x8*)(Ks + KSWZ(32 + r32, cb));
                  p0 = __builtin_amdgcn_mfma_f32_32x32x16_bf16(b0, qr[d0], p0, 0, 0, 0); p1 = __builtin_amdgcn_mfma_f32_32x32x16_bf16(b1, qr[d0], p1, 0, 0, 0);
                  if (d0 == 3) SBAR(); }
              if constexpr (DQK == 192) { const LAS unsigned char* Rs = lds + L_R + b * 8192;
                  const LAS unsigned char* qv = lds + L_QR + wid * 8192 + lane * 16 + ((U.rope && j >= nt0) ? 4096 : 0);
#pragma unroll
                  for (int d0 = 0; d0 < 4; ++d0) { const int cb = (d0 * 16 + hi * 8) * 2;
                      const bf16x8 b0 = *(const LAS bf16x8*)(Rs + RSWZ(r32, cb)), b1 = *(const LAS bf16x8*)(Rs + RSWZ(32 + r32, cb)), qf = *(const LAS bf16x8*)(qv + d0 * 1024);
                      p0 = __builtin_amdgcn_mfma_f32_32x32x16_bf16(b0, qf, p0, 0, 0, 0); p1 = __builtin_amdgcn_mfma_f32_32x32x16_bf16(b1, qf, p1, 0, 0, 0); } } }
#pragma unroll
            for (int r = 0; r < 16; ++r) { p0[r] *= C; p1[r] *= C; }
            float pmax = p0[0];
#pragma unroll
            for (int r = 1; r < 16; ++r) pmax = fmaxf(pmax, p0[r]);
#pragma unroll
            for (int r = 0; r < 16; ++r) pmax = fmaxf(pmax, p1[r]);
            { auto x = __builtin_amdgcn_permlane32_swap(__float_as_uint(pmax), __float_as_uint(pmax), false, false); pmax = fmaxf(__uint_as_float(x[0]), __uint_as_float(x[1])); }
            float alpha = 1.f;
            if (!__all(pmax - m_reg <= THRL)) { const float mn = fmaxf(m_reg, pmax); alpha = __builtin_amdgcn_exp2f(m_reg - mn); m_reg = mn; }
            float ps = 0.f;
#pragma unroll
            for (int r = 0; r < 16; ++r) { p0[r] = __builtin_amdgcn_exp2f(p0[r] - m_reg); p1[r] = __builtin_amdgcn_exp2f(p1[r] - m_reg); ps += p0[r] + p1[r]; }
            { auto x = __builtin_amdgcn_permlane32_swap(__float_as_uint(ps), __float_as_uint(ps), false, false); ps = __uint_as_float(x[0]) + __uint_as_float(x[1]); }
            l_reg = l_reg * alpha + ps;
            bf16x8 pa0, pa1, pa2, pa3;
#define PK4(P, BASE, OUT) do { unsigned a0 = cvtpk(P[BASE + 0], P[BASE + 1]), a1 = cvtpk(P[BASE + 2], P[BASE + 3]); unsigned b0 = cvtpk(P[BASE + 4], P[BASE + 5]), b1 = cvtpk(P[BASE + 6], P[BASE + 7]); \
        auto r0 = __builtin_amdgcn_permlane32_swap(a0, b0, false, false); auto r1 = __builtin_amdgcn_permlane32_swap(a1, b1, false, false); \
        v4u w = {r0[0], r1[0], r0[1], r1[1]}; OUT = __builtin_bit_cast(bf16x8, w); } while (0)
            PK4(p0, 0, pa0); PK4(p0, 8, pa1); PK4(p1, 0, pa2); PK4(p1, 8, pa3);
#undef PK4
            if (__any(alpha < 1.f)) { if (hi == 0) al_l[r32] = alpha; LDS_WAIT();
#pragma unroll
                for (int r = 0; r < 16; ++r) { const float av = al_l[crow(r, hi)];
#pragma unroll
                    for (int d = 0; d < 4; ++d) o[d][r] *= av; } }
            const int vb = vb0 + b * 16384;
            pv_one<0>(o[0], vb, pa0, pa1, pa2, pa3); pv_one<1>(o[1], vb, pa0, pa1, pa2, pa3); pv_one<2>(o[2], vb, pa0, pa1, pa2, pa3); pv_one<3>(o[3], vb, pa0, pa1, pa2, pa3);
        }
        VM_WAIT(); SWRITE(b ^ 1);
        __syncthreads();
    }
#undef SLOAD
#undef SWRITE
    if (hi == 0) li_l[r32] = l_reg;
    LDS_WAIT();
    bf16* Ow = U.O + (size_t)(wid * 32) * U.ldo;
#pragma unroll
    for (int r = 0; r < 16; ++r) { const int orow = crow(r, hi); const float rl = 1.f / li_l[orow];
#pragma unroll
        for (int d0 = 0; d0 < 4; ++d0) Ow[(size_t)orow * U.ldo + d0 * 32 + r32] = (bf16)f2bf(o[d0][r] * rl); }
}
#undef KSWZ
#undef RSWZ
#undef SBAR
}
constexpr int NPHASE = 20;
#ifndef PROBE_REP0
#define PROBE_REP0 1
#endif
#ifndef PROBE_REP4
#define PROBE_REP4 1
#endif
#ifndef PROBE_REP7
#define PROBE_REP7 1
#endif
#ifndef PROBE_REP14
#define PROBE_REP14 1
#endif
__device__ __forceinline__ unsigned queue_next(LAS unsigned char* lds, gu32* ctr, int home, unsigned n_per, int tid) {
    LAS unsigned* qw = (LAS unsigned*)(lds + LDSCTL_OFF + 64);
    __syncthreads();
    if (tid == 0) { unsigned r = 0xffffffffu;
        for (int k = 0; k < 8; ++k) { const int x = (home + k) & 7; const unsigned i = __hip_atomic_fetch_add(ctr + 64 * x, 1u, RLX_AGENT); if (i < n_per) { r = (unsigned)x * n_per + i; break; } }
        *qw = r; }
    __syncthreads();
    return (unsigned)__builtin_amdgcn_readfirstlane((int)*qw);
}

__device__ __forceinline__ void phase_even_hgrn(const Args& args, LAS unsigned char* lds, int tid, int vcu, int G) {
        { const bool fast = G >= 256; int it = vcu; const int step = fast ? (vcu < 128 ? 4096 : G - 128) : G;
          for (; it < 640; it += step) hg::hgrn_item(lds, args, it < 128 ? 1 : 0, it < 128 ? it : it - 128, tid); }
}

__device__ __forceinline__ void phase_even_attn(const Args& args, LAS unsigned char* lds, gu32* qctr, int home, int tid) {
    unsigned char* ws = args.ws; bf16* Bbuf = (bf16*)(ws + WS_B); bf16* Cbuf = (bf16*)(ws + WS_C);
        const bf16* nak = (const bf16*)(args.out + O_CKV); const bf16* nav = (const bf16*)(args.out + O_CKV + 2097152); const float* bt = (const float*)(ws + WS_BIAS);
        for (;;) {
            const unsigned uq = queue_next(lds, qctr, home, 96u, tid);
            if (uq == 0xffffffffu) break;
            const unsigned lx = uq / 96u, li = uq % 96u;
            const unsigned u = li < 64u ? ((lx + 8u * (li >> 3)) << 3) + (li & 7u) : 512u + lx + 8u * (li - 64u);
            att::Unit U; U.ldq = 4096; U.ldo = 2048; U.rope = nullptr; U.pos0 = 0; U.C = 0.08838834764831845f * LOG2E;
            const bf16* P2 = (const bf16*)(ws + WS_P2);
            if (u < 512u) { const int b = u >> 6, h = (u >> 3) & 7, qb = u & 7; const size_t row0 = (size_t)MC + b * LT + qb * 256;
                const int r0 = 4 * qb; int rs = r0 - 4; rs = rs < 0 ? 0 : (rs > 24 ? 24 : rs); int re = r0 - 1; re = re < 0 ? 0 : (re > 24 ? 24 : re); re += 8;
                U.Q = P2 + row0 * 4096 + 1024 + h * 128; U.O = Bbuf + row0 * 2048 + 1024 + h * 128;
                const bf16* kb = P2 + ((size_t)MC + b * LT + rs * 64) * 4096 + 2048 + h * 128;
                U.s0 = att::Seg{kb, kb + 1024, nullptr, 4096, re - rs};
                U.s1 = att::Seg{nak + (size_t)b * 512 * 1024 + h * 128, nav + (size_t)b * 512 * 1024 + h * 128, nullptr, 1024, 8};
                U.bias = bt + (size_t)h * 16 * 4096; U.r0 = r0; U.rs = rs;
                att::attn_unit<128, true>(lds, U, tid); }
            else { const int i = u - 512, b = i >> 3, h = i & 7; const size_t row0 = (size_t)b * CT;
                U.Q = P2 + row0 * 4096 + 1024 + h * 128; U.O = Bbuf + row0 * 2048 + 1024 + h * 128;
                const bf16* kb = P2 + row0 * 4096 + 2048 + h * 128;
                U.s0 = att::Seg{kb, kb + 1024, nullptr, 4096, 4}; U.s1 = att::Seg{kb, kb + 1024, nullptr, 4096, 0}; U.bias = nullptr; U.r0 = 0; U.rs = 0;
                att::attn_unit<128, false>(lds, U, tid); }
        }
}

__device__ __forceinline__ void phase_mla_attn(const Args& args, LAS unsigned char* lds, gu32* qctr, int home, int tid) {
    unsigned char* ws = args.ws; bf16* Bbuf = (bf16*)(ws + WS_B); bf16* Cbuf = (bf16*)(ws + WS_C);

        const bf16* qb_ = Cbuf; const bf16* kv = (const bf16*)(ws + WS_CKVX); const bf16* krot = (const bf16*)(ws + WS_D_KROT); const float* rope = (const float*)(ws + WS_ROPE);
        for (;;) {
            const unsigned uq = queue_next(lds, qctr, home, 192u, tid);
            if (uq == 0xffffffffu) break;
            const unsigned lx = uq / 192u, li = uq % 192u;
            const unsigned u = li < 128u ? ((lx + 8u * (li >> 3)) << 3) + (li & 7u) : 1024u + lx + 8u * (li - 128u);
            att::Unit U; U.ldq = 3072; U.ldo = 2048; U.bias = nullptr; U.r0 = 0; U.rs = 0; U.C = 0.07216878364870322f * LOG2E;
            if (u < 1024u) { const int b = u >> 7, h = (u >> 3) & 15, qb = u & 7; const size_t row0 = (size_t)MC + b * LT + qb * 256;
                U.Q = qb_ + row0 * 3072 + h * 192; U.O = Bbuf + row0 * 2048 + h * 128; U.rope = rope; U.pos0 = qb * 256;
                const bf16* kb = kv + ((size_t)MC + b * LT) * 4096 + h * 256; const bf16* kc = kv + ((size_t)MT + b * PAST) * 4096 + h * 256;
                U.s0 = att::Seg{kb, kb + 128, krot + ((size_t)MC + b * LT) * 64, 4096, 32}; U.s1 = att::Seg{kc, kc + 128, krot + ((size_t)MT + b * PAST) * 64, 4096, 8}; }
            else { const int i = u - 1024, b = i >> 4, h = i & 15; const size_t row0 = (size_t)b * CT;
                U.Q = qb_ + row0 * 3072 + h * 192; U.O = Bbuf + row0 * 2048 + h * 128; U.rope = nullptr; U.pos0 = 0;
                const bf16* kb = kv + row0 * 4096 + h * 256;
                U.s0 = att::Seg{kb, kb + 128, krot + row0 * 64, 4096, 4}; U.s1 = att::Seg{kb, kb + 128, krot + row0 * 64, 4096, 0}; }
            att::attn_unit<192, false>(lds, U, tid);
        }
}

__global__ void __launch_bounds__(512, 2) mega_fwd(Args args) {
    extern __shared__ __attribute__((aligned(16))) unsigned char lds_raw[];
    LAS unsigned char* lds = (LAS unsigned char*)lds_raw;
    const int tid = threadIdx.x, lane = tid & 63, wave = __builtin_amdgcn_readfirstlane(tid >> 6);
    const int G = gridDim.x; const int bx = blockIdx.x; const int vcu = (G % 8 == 0) ? (bx % 8) * (G / 8) + bx / 8 : bx;
    const int gw = vcu * 8 + wave, NGW = G * 8;
    const int home = (G % 8 == 0) ? (vcu / (G / 8)) & 7 : 0;
    unsigned char* ws = args.ws;
    gu32* ctl = (gu32*)(ws + WS_CTL);
    for (int u = tid; u < (LDS_BYTES - LDSCTL_OFF) / 4; u += 512) ((LAS unsigned*)(lds + LDSCTL_OFF))[u] = 0u;
    __syncthreads();
    volatile LAS unsigned* MISC = (volatile LAS unsigned*)(lds + MISC_OFF);
    XcdBarrier bar = xcd_barrier_post((unsigned*)(ws + WS_CTL) + CW_BAR + args.li * XCD_BAR_WORDS, MISC + 8);
    const int lo = args.ph_lo, hi = args.ph_hi;
#define IN(k) (lo <= (k) && (k) < hi)
#define SEAM(k) do { if (IN(k) && IN((k) + 1)) xcd_barrier(bar); } while (0)
    bf16* Bbuf = (bf16*)(ws + WS_B); bf16* Cbuf = (bf16*)(ws + WS_C); bf16* Dbuf = (bf16*)(ws + WS_D);
    const float* mod = (const float*)(ws + WS_MOD);
    const float* ng = args.in[I_NG];

    if (IN(0)) { phase_prologue(args, lds, tid, lane, wave, vcu, G);
#if PROBE_REP0 == 2
        xcd_barrier(bar); phase_prologue(args, lds, tid, lane, wave, vcu, G);
#endif
    }
    SEAM(0);
    if (IN(1)) phase_mod_reduce(args, gw, lane, NGW);
    SEAM(1);
    if (IN(2)) row_pass<false, true>(args.in[I_XP], args.in[I_XS], nullptr, nullptr, Bbuf, nullptr, nullptr, ng, mod, mod + 2048, gw, lane, NGW);
    SEAM(2);
    if (IN(3)) { pg8::Gemm g{Bbuf, (const bf16*)(ws + WS_WINE), MT, EVEN_IN, DM}; pg8::StaticOrder S; S.init(MT, EVEN_IN, G, bx);
        pg8::EpiT<3> E{Cbuf, EVEN_IN, nullptr, 0, args.out + O_NK, args.out + O_NV, (bf16*)(ws + WS_P2), (const float*)(ws + WS_LBT)};
        pg8::gemm_phase<pg8::EpiT<3>, pg8::StaticOrder, true, true>(lds, g, S, E); }
    SEAM(3);
    if (IN(4)) { phase_even_hgrn(args, lds, tid, vcu, G);
#if PROBE_REP4 == 2
        xcd_barrier(bar); phase_even_hgrn(args, lds, tid, vcu, G); xcd_barrier(bar);
#endif
        phase_even_attn(args, lds, ctl + CW_Q0, home, tid);
#if PROBE_REP4 == 3
        xcd_barrier(bar); phase_even_attn(args, lds, ctl + CW_Q0 + 512, home, tid);
#endif
#if PROBE_REP4 == 4
        xcd_barrier(bar); phase_even_hgrn(args, lds, tid, vcu, G); phase_even_attn(args, lds, ctl + CW_Q0 + 512, home, tid);
#endif
    }
    SEAM(4);
    if (IN(5)) phase_hgrn_combine(args, gw, lane, NGW);
    SEAM(5);
    if (IN(6)) { pg8::Gemm g{Bbuf, (const bf16*)(ws + WS_WOUTE), MT, DM, DM}; pg8::StaticOrder S; S.init(MT, DM, G, bx); pg8::EpiT<0> E{Dbuf, DM, nullptr, 0, nullptr, nullptr, nullptr, nullptr};
        pg8::gemm_phase<pg8::EpiT<0>, pg8::StaticOrder, true, true>(lds, g, S, E); }
    SEAM(6);
    if (IN(7)) { row_pass<true, true>(args.in[I_XP], args.in[I_XS], Dbuf, args.out, Bbuf, ng + 2048, mod + 2 * 2048, ng + 2 * 2048, mod + 3 * 2048, mod + 4 * 2048, gw, lane, NGW);
#if PROBE_REP7 == 2
        xcd_barrier(bar); row_pass<true, true>(args.in[I_XP], args.in[I_XS], Dbuf, args.out, Bbuf, ng + 2048, mod + 2 * 2048, ng + 2 * 2048, mod + 3 * 2048, mod + 4 * 2048, gw, lane, NGW);
#endif
    }
    SEAM(7);
    if (IN(8)) { pg8::Gemm g{Bbuf, (const bf16*)(ws + WS_W1_0), MT, DFF, DM}; pg8::StaticOrder S; S.init(MT, DFF, G, bx); pg8::EpiT<1> E{Cbuf, DFF, nullptr, 0, nullptr, nullptr, nullptr, nullptr};
        pg8::gemm_phase<pg8::EpiT<1>, pg8::StaticOrder, true, true>(lds, g, S, E); }
    SEAM(8);
    if (IN(9)) { pg8::Gemm g{Cbuf, (const bf16*)(ws + WS_W2_0), MT, DM, DFF}; pg8::StaticOrder S; S.init(MT, DM, G, bx); pg8::EpiT<0> E{Dbuf, DM, nullptr, 0, nullptr, nullptr, nullptr, nullptr};
        pg8::gemm_phase<pg8::EpiT<0>, pg8::StaticOrder, true, true>(lds, g, S, E); }
    SEAM(9);
    if (IN(10)) row_pass<true, true>(args.out, args.out + (size_t)MC * DM, Dbuf, args.out, Bbuf, ng + 3 * 2048, mod + 5 * 2048, ng + 4 * 2048, mod + 110592, mod + 110592 + 2048, gw, lane, NGW);
    SEAM(10);
    if (IN(11)) { pg8::Gemm g{Bbuf, (const bf16*)(ws + WS_WINO), MT, ODD_PAD, DM}; pg8::StaticOrder S; S.init(MT, ODD_PAD, G, bx); pg8::EpiT<2> E{nullptr, 0, (float*)(ws + WS_C), ODD_PAD, nullptr, nullptr, nullptr, nullptr};
        pg8::gemm_phase<pg8::EpiT<2>, pg8::StaticOrder, true, true>(lds, g, S, E); }
    SEAM(11);
    if (IN(12)) phase_mla_rows(args, gw, lane, NGW);
    SEAM(12);
    if (IN(13)) {
        { pg8::Gemm g{(const bf16*)(ws + WS_D_CQN), (const bf16*)(ws + WS_WUQ), MT, 3072, 512}; pg8::StaticOrder S; S.init(MT, 3072, G, bx); pg8::EpiT<0> E{Cbuf, 3072, nullptr, 0, nullptr, nullptr, nullptr, nullptr};
          pg8::gemm_phase<pg8::EpiT<0>, pg8::StaticOrder, true, true>(lds, g, S, E); }
        { pg8::Gemm g{(const bf16*)(ws + WS_D_CKVN), (const bf16*)(ws + WS_WUKV), MKV, 4096, 512}; pg8::StaticOrder S; S.init(MKV, 4096, G, bx); pg8::EpiT<0> E{(bf16*)(ws + WS_CKVX), 4096, nullptr, 0, nullptr, nullptr, nullptr, nullptr};
          pg8::gemm_phase<pg8::EpiT<0>, pg8::StaticOrder, true, true>(lds, g, S, E); }
    }
    SEAM(13);
    if (IN(14)) { phase_mla_attn(args, lds, ctl + CW_Q1, home, tid);
#if PROBE_REP14 == 2
        xcd_barrier(bar); phase_mla_attn(args, lds, ctl + CW_Q1 + 512, home, tid);
#endif
    }
    SEAM(14);
    if (IN(15)) { pg8::Gemm g{Bbuf, (const bf16*)(ws + WS_WOUTO), MT, DM, DM}; pg8::StaticOrder S; S.init(MT, DM, G, bx); pg8::EpiT<0> E{Dbuf, DM, nullptr, 0, nullptr, nullptr, nullptr, nullptr};
        pg8::gemm_phase<pg8::EpiT<0>, pg8::StaticOrder, true, true>(lds, g, S, E); }
    SEAM(15);
    { const float* mod1 = mod + 110592; const float* ng1 = ng + 4 * 2048;
    if (IN(16)) row_pass<true, true>(args.out, args.out + (size_t)MC * DM, Dbuf, args.out, Bbuf, ng1 + 2048, mod1 + 2 * 2048, ng1 + 2 * 2048, mod1 + 3 * 2048, mod1 + 4 * 2048, gw, lane, NGW);
    SEAM(16);
    if (IN(17)) { pg8::Gemm g{Bbuf, (const bf16*)(ws + WS_W1_1), MT, DFF, DM}; pg8::StaticOrder S; S.init(MT, DFF, G, bx); pg8::EpiT<1> E{Cbuf, DFF, nullptr, 0, nullptr, nullptr, nullptr, nullptr};
        pg8::gemm_phase<pg8::EpiT<1>, pg8::StaticOrder, true, true>(lds, g, S, E); }
    SEAM(17);
    if (IN(18)) { pg8::Gemm g{Cbuf, (const bf16*)(ws + WS_W2_1), MT, DM, DFF}; pg8::StaticOrder S; S.init(MT, DM, G, bx); pg8::EpiT<0> E{Dbuf, DM, nullptr, 0, nullptr, nullptr, nullptr, nullptr};
        pg8::gemm_phase<pg8::EpiT<0>, pg8::StaticOrder, true, true>(lds, g, S, E); }
    SEAM(18);
    if (IN(19)) row_pass<true, false>(args.out, args.out + (size_t)MC * DM, Dbuf, args.out, nullptr, ng1 + 3 * 2048, mod1 + 5 * 2048, nullptr, nullptr, nullptr, gw, lane, NGW);
    }
#undef IN
#undef SEAM
}

#ifndef MK_SPLITS
#define MK_SPLITS 1
#endif
extern "C" void kernel_launch(void* const* d_in, const int* in_sizes, int n_in, void* d_out, int out_size, void* d_ws, size_t ws_size, hipStream_t stream) {
    static int grid = 0;
    if (grid == 0) {
        if (n_in != 27 || (size_t)out_size != O_END || ws_size < WS_END) { fprintf(stderr, "kernel_launch: shape mismatch n_in %d out %d ws %zu (need %zu)\n", n_in, out_size, ws_size, (size_t)WS_END); grid = -1; return; }
        int dev = 0, cus = 0, per_cu = 0;
        if (hipGetDevice(&dev) != hipSuccess || hipDeviceGetAttribute(&cus, hipDeviceAttributeMultiprocessorCount, dev) != hipSuccess) { grid = -1; return; }
        if (hipFuncSetAttribute((const void*)mega_fwd, hipFuncAttributeMaxDynamicSharedMemorySize, LDS_BYTES) != hipSuccess) { fprintf(stderr, "kernel_launch: hipFuncSetAttribute failed\n"); grid = -1; return; }
        if (hipOccupancyMaxActiveBlocksPerMultiprocessor(&per_cu, (const void*)mega_fwd, 512, LDS_BYTES) != hipSuccess || per_cu < 1) { fprintf(stderr, "kernel_launch: occupancy query says %d\n", per_cu); }
        (void)hipGetLastError();
        grid = cus;
    }
    if (grid < 0) return;
    (void)hipMemsetAsync((char*)d_ws + WS_CTL, 0, CTL_ZERO_BYTES, stream);
    Args a{};
    for (int i = 0; i < 27; ++i) a.in[i] = (const float*)d_in[i];
    a.out = (float*)d_out; a.ws = (unsigned char*)d_ws; a.pad = 0;
#if MK_SPLITS == 1
    a.ph_lo = 0; a.ph_hi = NPHASE; a.li = 0;
    hipLaunchKernelGGL(mega_fwd, dim3(grid), dim3(512), LDS_BYTES, stream, a);
#else
    for (int k = 0; k < NPHASE; ++k) { a.ph_lo = k; a.ph_hi = k + 1; a.li = 0; hipLaunchKernelGGL(mega_fwd, dim3(grid), dim3(512), LDS_BYTES, stream, a); }
#endif
}
```

```cpp
#include <hip/hip_runtime.h>
#include <cstdio>
#include <cstdint>
namespace pg8 {
#define PG8_LAS __attribute__((address_space(3)))
typedef unsigned short bf16_t;
typedef short bf16x8 __attribute__((ext_vector_type(8)));
typedef float f32x4 __attribute__((ext_vector_type(4)));
typedef unsigned u32x4 __attribute__((ext_vector_type(4)));
constexpr int BM = 256, BK = 64, HALF = 128, HTB = HALF * BK * 2  , STAGE_BYTES = 8 * HTB, NXCD = 8, WGM = 8;

__host__ __device__ __forceinline__ int lds_byte(int r, int c) { const int st = (r >> 4) * 2 + (c >> 5), rr = r & 15, cc = c & 31, ob = rr * 64 + cc * 2; return st * 1024 + (ob ^ (((ob >> 9) & 1) << 5)); }
__host__ __device__ __forceinline__ void stage_rc(int b, int& R, int& C) { const int st = b / 1024, sb = b % 1024, swz = sb ^ (((sb >> 9) & 1) << 5); R = (st >> 1) * 16 + swz / 64; C = (st & 1) * 32 + (swz % 64) / 2; }
__host__ __device__ __forceinline__ int perm32(int rho) { const int n = rho >> 4, i = rho & 15; return 8 * (i >> 2) + 4 * n + (i & 3); }

struct Unit { int pm, pn; };
struct Gemm { const bf16_t* A; const bf16_t* Bt; int M, N, K; };

struct StaticOrder {
    int nM, nN, nwg, G, c;
    __host__ __device__ void init(int M, int N, int G_, int c_) { nM = M / BM; nN = N / BM; nwg = nM * nN; G = G_; c = c_; }
    __host__ __device__ bool next(int i, Unit& u) const {
        const long L = (long)i * G + c; if (L >= nwg) return false;
        int wgid = (int)L; { const int q = nwg / NXCD, r = nwg % NXCD, xcd = wgid % NXCD, off = wgid / NXCD; wgid = (xcd < r ? xcd * (q + 1) : r * (q + 1) + (xcd - r) * q) + off; }
        const int nig = WGM * nN, gid = wgid / nig, fm = gid * WGM, gsz = (nM - fm) < WGM ? (nM - fm) : WGM;
        u.pm = fm + ((wgid % nig) % gsz); u.pn = (wgid % nig) / gsz; return true;
    }
    __device__ __forceinline__ void a_ready(const Unit&) const {}
    __device__ __forceinline__ void done(const Unit&) const {}
};

__device__ __forceinline__ unsigned cvt_pk_bf16(float lo, float hi) { unsigned r; asm volatile("v_cvt_pk_bf16_f32 %0, %1, %2" : "=v"(r) : "v"(lo), "v"(hi)); return r; }
typedef float f32x2 __attribute__((ext_vector_type(2)));
template <int MODE> struct EpiT {
    static constexpr bool PERM = true, AFTER_DRAIN = false;
    bf16_t* O; int ldc; float* F; int ldf; float* side_k; float* side_v; bf16_t* O2; const float* side_lb;
    __device__ __forceinline__ void operator()(const f32x4 (&acc)[2][2][4][2], const Unit& u, int wr, int wc, int fr, int fq) const {
        const int row0 = u.pm * BM + wr * 64 + fr; const int col0 = u.pn * BM + wc * 32 + 8 * fq;
#pragma unroll
        for (int ai = 0; ai < 2; ++ai)
#pragma unroll
            for (int m = 0; m < 4; ++m) { const int row = row0 + ai * HALF + m * 16;
#pragma unroll
                for (int bj = 0; bj < 2; ++bj) { f32x4 v0 = acc[ai][bj][m][0], v1 = acc[ai][bj][m][1]; const int col = col0 + bj * HALF;
                    if (MODE == 1) {
#pragma unroll
                        for (int e = 0; e < 4; ++e) { float a = v0[e] > 0.f ? v0[e] : 0.f; v0[e] = a * a; float b = v1[e] > 0.f ? v1[e] : 0.f; v1[e] = b * b; } }
                    if (MODE == 2) { float* fp = F + (size_t)row * ldf + col; *(f32x4*)fp = v0; *(f32x4*)(fp + 4) = v1; }
                    else { u32x4 w; w.x = cvt_pk_bf16(v0[0], v0[1]); w.y = cvt_pk_bf16(v0[2], v0[3]); w.z = cvt_pk_bf16(v1[0], v1[1]); w.w = cvt_pk_bf16(v1[2], v1[3]);
                        if (MODE == 3) {
                            if (col < 4096) { const int kind = col >> 10, hh = (col >> 7) & 7, cc = col & 127; const bool ctxr = row < 8192; const int T = ctxr ? 256 : 2048; const int t = ctxr ? (row & 255) : ((row - 8192) & 2047);
                                unsigned char* tp = (unsigned char*)O + ((size_t)(row - t) * 8 + (size_t)(hh * T + t)) * 1536;
                                if (kind == 0) { float q[8] = {v0[0], v0[1], v0[2], v0[3], v1[0], v1[1], v1[2], v1[3]};
#pragma unroll
                                    for (int e = 0; e < 8; ++e) q[e] = q[e] * __builtin_amdgcn_rcpf(1.f + __builtin_amdgcn_exp2f(-1.4426950408889634f * q[e])) * 0.08838834764831845f;
                                    u32x4 wq; wq.x = cvt_pk_bf16(q[0], q[1]); wq.y = cvt_pk_bf16(q[2], q[3]); wq.z = cvt_pk_bf16(q[4], q[5]); wq.w = cvt_pk_bf16(q[6], q[7]); *(u32x4*)(tp + cc * 2) = wq; }
                                else if (kind == 3) *(u32x4*)(tp + 256 + cc * 2) = w;
                                else { const float* lbp = side_lb + (kind - 1) * 1024 + hh * 128 + cc; const f32x4 l0 = *(const f32x4*)lbp, l1 = *(const f32x4*)(lbp + 4); f32x4 f0, f1;
#pragma unroll
                                    for (int e = 0; e < 4; ++e) { f0[e] = l0[e] + (1.f - l0[e]) * __builtin_amdgcn_rcpf(1.f + __builtin_amdgcn_exp2f(-1.4426950408889634f * v0[e])); f1[e] = l1[e] + (1.f - l1[e]) * __builtin_amdgcn_rcpf(1.f + __builtin_amdgcn_exp2f(-1.4426950408889634f * v1[e])); }
                                    float* fp = (float*)(tp + 512 * kind) + cc; *(f32x4*)fp = f0; *(f32x4*)(fp + 4) = f1; } }
                            else *(u32x4*)(O2 + (size_t)row * 4096 + (col - 4096)) = w; }
                        else *(u32x4*)(O + (size_t)row * ldc + col) = w; }
                    if (MODE == 3) { if (row < 8192 && col >= 6144) { float* fp = (col < 7168) ? side_k + (size_t)row * 1024 + (col - 6144) : side_v + (size_t)row * 1024 + (col - 7168);
                        *(f32x4*)fp = v0; *(f32x4*)(fp + 4) = v1; } }
                } }
    }
};
template <class Epi, class Sched, bool ALIGN_EPI = false, bool SP2 = false>
__device__ __forceinline__ void gemm_phase(PG8_LAS unsigned char* lds, const Gemm g, const Sched& S, const Epi& E) {
    const int tid = threadIdx.x, wid = __builtin_amdgcn_readfirstlane(tid >> 6), lane = tid & 63, wr = wid >> 2, wc = wid & 3, fr = lane & 15, fq = lane >> 4;
    const int K = g.K, nt = K / BK;
    unsigned voffA[2], voffB[2];
#pragma unroll
    for (int i = 0; i < 2; ++i) { int R, C; stage_rc(tid * 16 + i * 8192, R, C); const int Rb = Epi::PERM ? ((R & ~31) + perm32(R & 31)) : R;
        voffA[i] = (unsigned)(R * K + C) * 2u; voffB[i] = (unsigned)(Rb * K + C) * 2u; }
    const size_t kstep = (size_t)(BK * 2);
    const size_t hstep = (size_t)HALF * K * 2;
    const size_t tstep = 2 * hstep;
    const unsigned ldsw = (unsigned)wid * 1024u;
    const int aoff = lds_byte(wr * 64 + fr, fq * 8), boff = lds_byte(wc * 32 + fr, fq * 8);
#define PG8_SA(b, h) (((b) * 2 + (h)) * HTB)
#define PG8_SB(b, h) ((4 + (b) * 2 + (h)) * HTB)
#define PG8_STAGE(bufoff, gbase, voff) do { _Pragma("unroll") for (int _i = 0; _i < 2; ++_i) \
        __builtin_amdgcn_global_load_lds((const unsigned*)((const char*)(gbase) + (voff)[_i]), (PG8_LAS unsigned*)(lds + (bufoff) + ldsw + _i * 8192), 16, 0, 0); } while (0)
#define PG8_LDA(dst, b, h) do { _Pragma("unroll") for (int m = 0; m < 4; ++m) _Pragma("unroll") for (int k = 0; k < 2; ++k) dst[m][k] = *(const PG8_LAS bf16x8*)(lds + PG8_SA(b, h) + aoff + m * 2048 + k * 1024); } while (0)
#define PG8_LDB(dst, b, h) do { _Pragma("unroll") for (int n = 0; n < 2; ++n) _Pragma("unroll") for (int k = 0; k < 2; ++k) dst[n][k] = *(const PG8_LAS bf16x8*)(lds + PG8_SB(b, h) + boff + n * 2048 + k * 1024); } while (0)
#define PG8_MMA(ai, bj, At, Bt) do { __builtin_amdgcn_s_setprio(1); _Pragma("unroll") for (int m = 0; m < 4; ++m) _Pragma("unroll") for (int n = 0; n < 2; ++n) _Pragma("unroll") for (int k = 0; k < 2; ++k) \
        acc[ai][bj][m][n] = __builtin_amdgcn_mfma_f32_16x16x32_bf16(Bt[n][k], At[m][k], acc[ai][bj][m][n], 0, 0, 0); __builtin_amdgcn_s_setprio(0); } while (0)
#define PG8_WAIT_V(n) asm volatile("s_waitcnt vmcnt(" #n ")" ::: "memory")
#define PG8_WAIT_L(n) asm volatile("s_waitcnt lgkmcnt(" #n ")" ::: "memory")
#define PG8_BAR __builtin_amdgcn_s_barrier()
#define PG8_SCHED __builtin_amdgcn_sched_barrier(0)
    Unit cur, nxt; int ui = 0;
    if (!S.next(0, cur)) return;
    f32x4 acc[2][2][4][2];
#pragma unroll
    for (int a = 0; a < 2; ++a)
#pragma unroll
        for (int b = 0; b < 2; ++b)
#pragma unroll
            for (int m = 0; m < 4; ++m)
#pragma unroll
                for (int n = 0; n < 2; ++n) acc[a][b][m][n] = (f32x4){0.f, 0.f, 0.f, 0.f};
    bf16x8 At[4][2], B0[2][2], B1[2][2];
    const char* cA = (const char*)g.A + (size_t)cur.pm * tstep; const char* cB = (const char*)g.Bt + (size_t)cur.pn * tstep;
    S.a_ready(cur);
    if constexpr (SP2) {
        PG8_STAGE(PG8_SB(0, 0), cB, voffB); PG8_STAGE(PG8_SB(0, 1), cB + hstep, voffB); PG8_STAGE(PG8_SA(0, 0), cA, voffA); PG8_STAGE(PG8_SA(0, 1), cA + hstep, voffA);
        if (wr == 1) PG8_BAR;
        PG8_WAIT_V(2); PG8_BAR;
        PG8_STAGE(PG8_SB(1, 0), cB + kstep, voffB); PG8_STAGE(PG8_SA(1, 0), cA + kstep, voffA); PG8_STAGE(PG8_SB(1, 1), cB + hstep + kstep, voffB);
        PG8_WAIT_V(6); PG8_BAR;
    } else {
        PG8_STAGE(PG8_SB(0, 0), cB, voffB); PG8_STAGE(PG8_SA(0, 0), cA, voffA); PG8_STAGE(PG8_SB(0, 1), cB + hstep, voffB); PG8_STAGE(PG8_SA(0, 1), cA + hstep, voffA);
        if (wr == 1) PG8_BAR;
        PG8_WAIT_V(4); PG8_BAR;
        PG8_STAGE(PG8_SB(1, 0), cB + kstep, voffB); PG8_STAGE(PG8_SA(1, 0), cA + kstep, voffA); PG8_STAGE(PG8_SB(1, 1), cB + hstep + kstep, voffB);
        PG8_WAIT_V(6); PG8_BAR;
    }
    for (;;) {
        const bool has_next = S.next(ui + 1, nxt);
        const char* nA = has_next ? (const char*)g.A + (size_t)nxt.pm * tstep : cA; const char* nB = has_next ? (const char*)g.Bt + (size_t)nxt.pn * tstep : cB;
        for (int t = 0; t < nt; t += 2) {
            const bool last = (t == nt - 2);
            const char* a1 = cA + (size_t)(t + 1) * kstep;
            const char* a2 = last ? nA : cA + (size_t)(t + 2) * kstep; const char* b2 = last ? nB : cB + (size_t)(t + 2) * kstep;
            const char* a3 = a2 + kstep; const char* b3 = b2 + kstep;
            if (last && has_next) S.a_ready(nxt);
            if constexpr (SP2) {
            PG8_LDB(B0, 0, 0); PG8_LDB(B1, 0, 1); PG8_SCHED; PG8_LDA(At, 0, 0); PG8_STAGE(PG8_SA(1, 1), a1 + hstep, voffA);
            PG8_WAIT_V(8); PG8_WAIT_L(0); PG8_BAR; PG8_MMA(0, 0, At, B0); PG8_MMA(0, 1, At, B1); PG8_BAR; PG8_SCHED;
            PG8_LDA(At, 0, 1); PG8_STAGE(PG8_SB(0, 0), b2, voffB); PG8_STAGE(PG8_SB(0, 1), b2 + hstep, voffB); PG8_STAGE(PG8_SA(0, 0), a2, voffA);
            PG8_WAIT_V(8); PG8_WAIT_L(0); PG8_BAR; PG8_MMA(1, 0, At, B0); PG8_MMA(1, 1, At, B1); PG8_BAR; PG8_SCHED;
            PG8_LDB(B0, 1, 0); PG8_LDB(B1, 1, 1); PG8_SCHED; PG8_LDA(At, 1, 0); PG8_STAGE(PG8_SA(0, 1), a2 + hstep, voffA);
            PG8_WAIT_V(8); PG8_WAIT_L(0); PG8_BAR; PG8_MMA(0, 0, At, B0); PG8_MMA(0, 1, At, B1); PG8_BAR; PG8_SCHED;
            PG8_LDA(At, 1, 1); PG8_STAGE(PG8_SB(1, 0), b3, voffB); PG8_STAGE(PG8_SB(1, 1), b3 + hstep, voffB); PG8_STAGE(PG8_SA(1, 0), a3, voffA);
            PG8_WAIT_V(8); PG8_WAIT_L(0); PG8_BAR; PG8_MMA(1, 0, At, B0); PG8_MMA(1, 1, At, B1); PG8_BAR; PG8_SCHED;
            } else {
            PG8_LDB(B0, 0, 0); PG8_SCHED; PG8_LDA(At, 0, 0); PG8_STAGE(PG8_SA(1, 1), a1 + hstep, voffA);
            PG8_WAIT_L(8); PG8_BAR; PG8_WAIT_L(0); PG8_MMA(0, 0, At, B0); PG8_BAR; PG8_SCHED;
            PG8_LDB(B1, 0, 1); PG8_STAGE(PG8_SB(0, 0), b2, voffB);
            PG8_BAR; PG8_WAIT_L(0); PG8_MMA(0, 1, At, B1); PG8_BAR;
            PG8_LDA(At, 0, 1); PG8_STAGE(PG8_SA(0, 0), a2, voffA);
            PG8_BAR; PG8_WAIT_L(0); PG8_MMA(1, 0, At, B0); PG8_BAR; PG8_SCHED;
            PG8_STAGE(PG8_SB(0, 1), b2 + hstep, voffB);
            PG8_WAIT_V(6); PG8_BAR; PG8_MMA(1, 1, At, B1); PG8_BAR;
            PG8_LDB(B0, 1, 0); PG8_SCHED; PG8_LDA(At, 1, 0); PG8_STAGE(PG8_SA(0, 1), a2 + hstep, voffA);
            PG8_WAIT_L(8); PG8_BAR; PG8_WAIT_L(0); PG8_MMA(0, 0, At, B0); PG8_BAR; PG8_SCHED;
            PG8_LDB(B1, 1, 1); PG8_STAGE(PG8_SB(1, 0), b3, voffB);
            PG8_BAR; PG8_WAIT_L(0); PG8_MMA(0, 1, At, B1); PG8_BAR;
            PG8_LDA(At, 1, 1); PG8_STAGE(PG8_SA(1, 0), a3, voffA);
            PG8_BAR; PG8_WAIT_L(0); PG8_MMA(1, 0, At, B0); PG8_BAR; PG8_SCHED;
            PG8_STAGE(PG8_SB(1, 1), b3 + hstep, voffB);
            PG8_WAIT_V(6); PG8_BAR; PG8_MMA(1, 1, At, B1); PG8_BAR;
            }
        }
        if constexpr (ALIGN_EPI) { if (wr == 0) PG8_BAR; }
        if constexpr (!Epi::AFTER_DRAIN) { E(acc, cur, wr, wc, fr, fq); S.done(cur); }
        if (!has_next) break;
#pragma unroll
        for (int a = 0; a < 2; ++a)
#pragma unroll
            for (int b = 0; b < 2; ++b)
#pragma unroll
                for (int m = 0; m < 4; ++m)
#pragma unroll
                    for (int n = 0; n < 2; ++n) acc[a][b][m][n] = (f32x4){0.f, 0.f, 0.f, 0.f};
        cur = nxt; cA = nA; cB = nB; ++ui;
        if constexpr (ALIGN_EPI) { if (wr == 1) PG8_BAR; }
    }
    PG8_WAIT_V(0);
    if constexpr (!ALIGN_EPI) { if (wr == 0) PG8_BAR; }
    PG8_BAR;
    if constexpr (Epi::AFTER_DRAIN) { E.fused(acc, cur, wr, wc, fr, fq, lds, wid, lane); S.done(cur); }
#undef PG8_SA
#undef PG8_SB
#undef PG8_STAGE
#undef PG8_LDA
#undef PG8_LDB
#undef PG8_MMA
#undef PG8_WAIT_V
#undef PG8_WAIT_L
#undef PG8_BAR
#undef PG8_SCHED
}
}
constexpr int DM = 2048, DFF = 8192;
constexpr int CB = 32, CT = 256, LBT = 8, LT = 2048, PAST = 512;
constexpr int MC = CB * CT, ML = LBT * LT, MT = MC + ML;
constexpr int MKV = MT + LBT * PAST;
constexpr int EVEN_IN = 8192, ODD_IN = 1088, ODD_PAD = 1280;
constexpr float EPS = 1e-6f;
constexpr float LOG2E = 1.4426950408889634f;
constexpr size_t O_Y = 0, O_SF = (size_t)MT * DM, O_SB = O_SF + 4194304, O_NK = O_SB + 4194304, O_NV = O_NK + 8388608, O_CKV = O_NV + 8388608, O_KPE = O_CKV + 4194304, O_END = O_KPE + 524288;
constexpr size_t MiB = 1u << 20;
constexpr size_t WS_CTL = 0, CTL_ZERO_BYTES = 256 * 1024;
constexpr size_t WS_MOD = 1 * MiB;
constexpr size_t WS_ROPE = 2 * MiB;
constexpr size_t WS_BIAS = 3 * MiB;
constexpr size_t WS_MODP = 5 * MiB;
constexpr size_t WS_WINE = 19 * MiB, WS_WOUTE = 51 * MiB, WS_W1_0 = 59 * MiB, WS_W2_0 = 91 * MiB, WS_W1_1 = 123 * MiB, WS_W2_1 = 155 * MiB;
constexpr size_t WS_WINO = 187 * MiB, WS_WUQ = 192 * MiB, WS_WUKV = 195 * MiB, WS_WOUTO = 199 * MiB;
constexpr size_t WS_B = 207 * MiB;
constexpr size_t WS_C = 303 * MiB;
constexpr size_t WS_CKVX = WS_C + 144 * MiB;
constexpr size_t WS_D = 687 * MiB;
constexpr size_t WS_D_CQN = WS_D, WS_D_CKVN = WS_D + 24 * MiB, WS_D_KROT = WS_D + 52 * MiB;
constexpr size_t WS_SCAN = WS_C, WS_P2 = WS_C + 288 * MiB;
constexpr size_t WS_LBT = WS_ROPE + 65536;
constexpr size_t WS_END = 783 * MiB;
constexpr int CW_BAR = 4096, CW_Q0 = 8192, CW_Q1 = 8192 + 1024, CW_Q2 = 8192 + 2048;
constexpr int RING_BYTES = 155648, LDSCTL_OFF = RING_BYTES, MISC_OFF = LDSCTL_OFF + 320, LDS_BYTES = 163840;

#define GAS __attribute__((address_space(1)))
#define LAS __attribute__((address_space(3)))
typedef unsigned short bf16;
typedef unsigned v4u __attribute__((ext_vector_type(4)));
typedef unsigned v2u __attribute__((ext_vector_type(2)));
typedef float f32x4 __attribute__((ext_vector_type(4)));
typedef float f32x16 __attribute__((ext_vector_type(16)));
typedef short bf16x8 __attribute__((ext_vector_type(8)));
typedef short s16x4 __attribute__((ext_vector_type(4)));
typedef GAS unsigned gu32;
#define RLX_AGENT __ATOMIC_RELAXED, __HIP_MEMORY_SCOPE_AGENT
#define LDS_WAIT() asm volatile("s_waitcnt lgkmcnt(0)" ::: "memory")
#define VM_WAIT() asm volatile("s_waitcnt vmcnt(0)" ::: "memory")
__device__ __forceinline__ unsigned f2bf(float f) { unsigned u = __builtin_bit_cast(unsigned, f); return (u + 0x7fffu + ((u >> 16) & 1u)) >> 16; }
__device__ __forceinline__ unsigned pk2(float lo, float hi) { return f2bf(lo) | (f2bf(hi) << 16); }
__device__ __forceinline__ float bf2f(unsigned short b) { return __builtin_bit_cast(float, (unsigned)b << 16); }
__device__ __forceinline__ float bflo(unsigned w) { return __builtin_bit_cast(float, w << 16); }
__device__ __forceinline__ float bfhi(unsigned w) { return __builtin_bit_cast(float, w & 0xffff0000u); }
__device__ __forceinline__ float wave_sum(float v) {
#pragma unroll
    for (int o = 1; o < 64; o <<= 1) v += __shfl_xor(v, o);
    return v;
}
#define XB_TMO      128
#define XB_XCNT(j)  (256  + 64 * (j))
#define XB_XSUB(j)  (1280 + 64 * (j))
#define XB_XGEN(j)  (2304 + 64 * (j))
#define XB_TOP      3328
#define XB_TOPGEN   3392
#define XCD_BAR_WORDS 3456
#define XB_SPIN_CAP (1u << 18)

__device__ __forceinline__ unsigned xb_ld(unsigned* p)              { return __hip_atomic_load(p, __ATOMIC_RELAXED, __HIP_MEMORY_SCOPE_AGENT); }
__device__ __forceinline__ unsigned xb_add(unsigned* p, unsigned v) { return __hip_atomic_fetch_add(p, v, __ATOMIC_RELAXED, __HIP_MEMORY_SCOPE_AGENT); }
__device__ __forceinline__ unsigned xb_xcc_id() { return (unsigned)__builtin_amdgcn_s_getreg((3 << 11) | 20) & 0xFu; }
#define XB_SPIN(cond, bar) do { unsigned _sp = 0; while (cond) { __builtin_amdgcn_s_sleep(1); \
    if ((++_sp & 255u) == 0u) { if (xb_ld(&(bar)[XB_TMO])) break; if (_sp > XB_SPIN_CAP) { atomicAdd(&(bar)[XB_TMO], 1u); break; } } } } while (0)

struct XcdBarrier {
    unsigned* bar; unsigned x;
    volatile LAS unsigned* st;
};

__device__ __forceinline__ XcdBarrier xcd_barrier_post(unsigned* bar, volatile LAS unsigned* st) {
    XcdBarrier b; b.bar = bar; b.x = xb_xcc_id(); b.st = st;
    if (threadIdx.x == 0) (void)xb_add(&bar[XB_XCNT(b.x)], 1u);
    return b;
}
__device__ __forceinline__ void xcd_barrier_complete(unsigned* bar, unsigned x, unsigned& nloc, unsigned& nx) {
    const unsigned G = gridDim.x * gridDim.y * gridDim.z;
    unsigned sum, cnt, mine, sp = 0u;
    for (;;) {
        sum = 0u; cnt = 0u; mine = 0u;
#pragma unroll
        for (unsigned j = 0; j < 16; ++j) { const unsigned c = xb_ld(&bar[XB_XCNT(j)]); sum += c; cnt += (c > 0u) ? 1u : 0u; mine = (j == x) ? c : mine; }
        if (sum == G) break;
        __builtin_amdgcn_s_sleep(1);
        if ((++sp & 255u) == 0u) { if (xb_ld(&bar[XB_TMO])) break; if (sp > XB_SPIN_CAP) { atomicAdd(&bar[XB_TMO], 1u); break; } }
    }
    nloc = mine > 0u ? mine : 1u; nx = cnt > 0u ? cnt : 1u;
}

__device__ __forceinline__ void xcd_barrier(const XcdBarrier& b) {
    asm volatile("s_waitcnt vmcnt(0)" ::: "memory");
    __syncthreads();
    if (threadIdx.x == 0) {
        unsigned* bar = b.bar;
        __builtin_amdgcn_s_waitcnt(0);
        unsigned nloc = b.st[0], nx = b.st[1];
        if (nloc == 0u) { xcd_barrier_complete(bar, b.x, nloc, nx); b.st[0] = nloc; b.st[1] = nx; }
        const unsigned old = xb_add(&bar[XB_XSUB(b.x)], 1u);
        const unsigned gen = old / nloc;
        if (old + 1u == (gen + 1u) * nloc) {
            __builtin_amdgcn_fence(__ATOMIC_RELEASE, "agent");
            asm volatile("s_waitcnt vmcnt(0)" ::: "memory");
            const unsigned og = xb_add(&bar[XB_TOP], 1u);
            const unsigned tg = og / nx;
            if (og + 1u == (tg + 1u) * nx) xb_add(&bar[XB_TOPGEN], 1u);
            else XB_SPIN(xb_ld(&bar[XB_TOPGEN]) == tg, bar);
            __builtin_amdgcn_fence(__ATOMIC_ACQUIRE, "agent");
            xb_add(&bar[XB_XGEN(b.x)], 1u);
            asm volatile("s_waitcnt vmcnt(0)" ::: "memory");
        } else {
            XB_SPIN(xb_ld(&bar[XB_XGEN(b.x)]) == gen, bar);
            __builtin_amdgcn_fence(__ATOMIC_ACQUIRE, "agent");
            asm volatile("s_waitcnt vmcnt(0)" ::: "memory");
        }
    }
    __syncthreads();
}
struct Args { const float* in[27]; float* out; unsigned char* ws; int ph_lo, ph_hi, li, pad; };
enum { I_XP = 0, I_XS, I_SF, I_SB, I_NAK, I_NAV, I_CKV, I_KPE, I_C, I_CCTX, I_ADAW, I_ADAB, I_NG, I_LBF, I_LBB, I_WINE, I_HNG, I_RPB, I_WOUTE, I_WINO, I_QNG, I_WUQ, I_KVNG, I_WUKV, I_WOUTO, I_W1, I_W2 };

__device__ __forceinline__ void p0_transpose_item(const float* W, int K, int N, bf16* WT, LAS float* scr, int item, int lane) {
    const int nblk = N / 32, kb = item / nblk, nb = item % nblk, k0 = 64 * kb, n0 = 32 * nb;
#pragma unroll 8
    for (int i = 0; i < 32; ++i) { const int kk = 2 * i + (lane >> 5); scr[kk * 33 + (lane & 31)] = W[(size_t)(k0 + kk) * N + n0 + (lane & 31)]; }
    LDS_WAIT(); asm volatile("" ::: "memory");
    const int c = lane & 7;
#pragma unroll
    for (int j = 0; j < 4; ++j) { const int n = (lane >> 3) + 8 * j; const LAS float* s = scr + (8 * c) * 33 + n;
        v4u o; o.x = pk2(s[0 * 33], s[1 * 33]); o.y = pk2(s[2 * 33], s[3 * 33]); o.z = pk2(s[4 * 33], s[5 * 33]); o.w = pk2(s[6 * 33], s[7 * 33]);
        *(GAS v4u*)(WT + (size_t)(n0 + n) * K + k0 + 8 * c) = o; }
    LDS_WAIT(); asm volatile("" ::: "memory");
}

constexpr int TRL_B = 32 * 64, TRL_C1 = 32 * 256, TRL_C2 = 128 * 64, TRL_D = 32 * 34, TRL_E = 8 * 96, TRL_F = 8 * 128, TRL_G = 32 * 64;
constexpr int TRL_ITEMS = TRL_B + 2 * TRL_C1 + 2 * TRL_C2 + TRL_D + TRL_E + TRL_F + TRL_G;
__device__ __forceinline__ void tr_late_item(const Args& a, LAS float* scr, int it, int lane) {
    unsigned char* ws = a.ws; int r = it;
    if (r < TRL_B) { p0_transpose_item(a.in[I_WOUTE], 2048, 2048, (bf16*)(ws + WS_WOUTE), scr, r, lane); return; } r -= TRL_B;
    if (r < TRL_C1) { p0_transpose_item(a.in[I_W1], 2048, 8192, (bf16*)(ws + WS_W1_0), scr, r, lane); return; } r -= TRL_C1;
    if (r < TRL_C1) { p0_transpose_item(a.in[I_W1] + (size_t)2048 * 8192, 2048, 8192, (bf16*)(ws + WS_W1_1), scr, r, lane); return; } r -= TRL_C1;
    if (r < TRL_C2) { p0_transpose_item(a.in[I_W2], 8192, 2048, (bf16*)(ws + WS_W2_0), scr, r, lane); return; } r -= TRL_C2;
    if (r < TRL_C2) { p0_transpose_item(a.in[I_W2] + (size_t)2048 * 8192, 8192, 2048, (bf16*)(ws + WS_W2_1), scr, r, lane); return; } r -= TRL_C2;
    if (r < TRL_D) { p0_transpose_item(a.in[I_WINO], 2048, 1088, (bf16*)(ws + WS_WINO), scr, r, lane); return; } r -= TRL_D;
    if (r < TRL_E) { p0_transpose_item(a.in[I_WUQ], 512, 3072, (bf16*)(ws + WS_WUQ), scr, r, lane); return; } r -= TRL_E;
    if (r < TRL_F) { p0_transpose_item(a.in[I_WUKV], 512, 4096, (bf16*)(ws + WS_WUKV), scr, r, lane); return; } r -= TRL_F;
    p0_transpose_item(a.in[I_WOUTO], 2048, 2048, (bf16*)(ws + WS_WOUTO), scr, r, lane);
}

__device__ __forceinline__ void phase_prologue(const Args& a, LAS unsigned char* lds, int tid, int lane, int wave, int vcu, int G) {
    const int gw = vcu * 8 + wave, NGW = G * 8;
    unsigned char* ws = a.ws;
    {
        LAS float* scr = (LAS float*)(lds + wave * 16384);
        for (int it = gw; it < 32 * 256; it += NGW) p0_transpose_item(a.in[I_WINE], 2048, 8192, (bf16*)(ws + WS_WINE), scr, it, lane);
    }
    const size_t gt = (size_t)gw * 64 + lane, NGT = (size_t)NGW * 64;
    { GAS v4u* z = (GAS v4u*)(ws + WS_WINO + (size_t)1088 * 2048 * 2); for (size_t i = gt; i < (size_t)192 * 2048 * 2 / 16; i += NGT) z[i] = (v4u){0u, 0u, 0u, 0u}; }
    { float* bt = (float*)(ws + WS_BIAS); const float* rpb = a.in[I_RPB];
      for (size_t i = gt; i < (size_t)8 * 16 * 64 * 64; i += NGT) { const int kc = (int)(i & 63), qc = (int)((i >> 6) & 63), dr = (int)((i >> 12) & 15), hh = (int)(i >> 16);
          int cs = qc - 8; cs = cs < 0 ? 0 : (cs > 48 ? 48 : cs); const bool ok = kc >= cs && kc < cs + 16; int ci = kc - qc + 15; ci = ci < 0 ? 0 : (ci > 30 ? 30 : ci);
          bt[i] = dr == 15 ? 0.f : (ok ? rpb[(hh * 15 + dr) * 31 + ci] * 11.313708498984761f : -1e30f); } }
    { float* rt = (float*)(ws + WS_ROPE);
      for (size_t i = gt; i < 64 * 32; i += NGT) { const int pos = (int)(i >> 5), j = (int)(i & 31), i16 = j & 15; const float inv = powf(10000.f, -(float)(2 * i16) / 32.f); const float ang = (float)pos * inv;
          rt[i] = j < 16 ? cosf(ang) : sinf(ang); } }
    { const f32x4* sk = (const f32x4*)a.in[I_NAK]; const f32x4* sv = (const f32x4*)a.in[I_NAV]; GAS v2u* dk = (GAS v2u*)(a.out + O_CKV); GAS v2u* dv = (GAS v2u*)(a.out + O_CKV + 2097152);
      for (size_t i = gt; i < (size_t)4194304 / 4; i += NGT) { const f32x4 x = sk[i], y = sv[i]; dk[i] = (v2u){pk2(x.x, x.y), pk2(x.z, x.w)}; dv[i] = (v2u){pk2(y.x, y.y), pk2(y.z, y.w)}; } }
    { float* lt = (float*)(ws + WS_LBT);
      for (size_t i = gt; i < 2048; i += NGT) { const float* lbp = (i < 1024 ? a.in[I_LBF] : a.in[I_LBB]) + (i & 1023); const float x0 = lbp[0], x1 = lbp[1024], x2 = lbp[2048]; const float mx = fmaxf(x0, fmaxf(x1, x2));
          const float e0 = __expf(x0 - mx), e1 = __expf(x1 - mx), e2 = __expf(x2 - mx); lt[i] = e0 / (e0 + e1 + e2); } }
    __syncthreads();
    {
        LAS float* S = (LAS float*)lds;
        for (int i = tid; i < 9 * 2048; i += 512) { const int r = i >> 11, k = i & 2047; const float x = r == 0 ? a.in[I_CCTX][k] : a.in[I_C][(r - 1) * 2048 + k]; S[k * 12 + r] = x / (1.f + __expf(-x)); }
        __syncthreads();
        float* modp = (float*)(ws + WS_MODP);
        for (int task = gw; task < 2 * 48 * 16; task += NGW) {
            const int l = task / 768, rem = task % 768, cg = rem >> 4, ks = rem & 15, col = cg * 256 + lane * 4;
            const float* W = a.in[I_ADAW] + ((size_t)l * 2048 + ks * 128) * 12288 + col;
            f32x4 acc[9];
#pragma unroll
            for (int r = 0; r < 9; ++r) acc[r] = (f32x4){0.f, 0.f, 0.f, 0.f};
#pragma unroll 4
            for (int kk = 0; kk < 128; ++kk) { const f32x4 w = *(const f32x4*)(W + (size_t)kk * 12288); const LAS f32x4* sp = (const LAS f32x4*)(S + (ks * 128 + kk) * 12);
                const f32x4 s0 = sp[0], s1 = sp[1], s2 = sp[2];
                acc[0] += w * s0.x; acc[1] += w * s0.y; acc[2] += w * s0.z; acc[3] += w * s0.w; acc[4] += w * s1.x; acc[5] += w * s1.y; acc[6] += w * s1.z; acc[7] += w * s1.w; acc[8] += w * s2.x; }
#pragma unroll
            for (int r = 0; r < 9; ++r) *(f32x4*)(modp + ((size_t)(l * 16 + ks) * 9 + r) * 12288 + col) = acc[r];
        }
    }
}

__device__ __forceinline__ void phase_mod_reduce(const Args& a, int gw, int lane, int NGW) {
    const float* modp = (const float*)(a.ws + WS_MODP); float* mod = (float*)(a.ws + WS_MOD);
    for (size_t i = (size_t)gw * 64 + lane; i < (size_t)2 * 9 * 12288; i += (size_t)NGW * 64) { const int l = (int)(i / 110592), rc = (int)(i % 110592), col = rc % 12288;
        float s = a.in[I_ADAB][l * 12288 + col];
#pragma unroll
        for (int ks = 0; ks < 16; ++ks) s += modp[(size_t)(l * 16 + ks) * 110592 + rc];
        mod[i] = s; }
}

template <bool POST, bool PRE>
__device__ __forceinline__ void row_pass(const float* xc, const float* xs, const bf16* y, float* xdst, bf16* hdst, const float* gpost, const float* gate0, const float* gpre, const float* shift0, const float* scale0,
                                         int gw, int lane, int NGW) {
    for (int m = gw; m < MT; m += NGW) {
        const int grp = m < MC ? 0 : 1 + ((m - MC) >> 11);
        const float* xr = (m < MC) ? xc + (size_t)m * DM : xs + (size_t)(m - MC) * DM;
        f32x4 v[8];
#pragma unroll
        for (int j = 0; j < 8; ++j) v[j] = *(const f32x4*)(xr + 4 * lane + 256 * j);
        if (POST) {
            const bf16* yr = y + (size_t)m * DM; f32x4 t[8]; float ss = 0.f;
#pragma unroll
            for (int j = 0; j < 8; ++j) { const v2u w = *(const v2u*)(yr + 4 * lane + 256 * j); t[j] = (f32x4){bflo(w.x), bfhi(w.x), bflo(w.y), bfhi(w.y)}; ss += (t[j].x * t[j].x + t[j].y * t[j].y) + (t[j].z * t[j].z + t[j].w * t[j].w); }
            const float rs = rsqrtf(wave_sum(ss) * (1.f / DM) + EPS);
            const float* gt = gate0 + (size_t)grp * 12288;
#pragma unroll
            for (int j = 0; j < 8; ++j) { const f32x4 g = *(const f32x4*)(gpost + 4 * lane + 256 * j), ga = *(const f32x4*)(gt + 4 * lane + 256 * j); v[j] = v[j] + ga * (t[j] * rs * g); }
            float* xo = xdst + (size_t)m * DM;
#pragma unroll
            for (int j = 0; j < 8; ++j) *(f32x4*)(xo + 4 * lane + 256 * j) = v[j];
        }
        if (PRE) {
            float ss = 0.f;
#pragma unroll
            for (int j = 0; j < 8; ++j) ss += (v[j].x * v[j].x + v[j].y * v[j].y) + (v[j].z * v[j].z + v[j].w * v[j].w);
            const float rs = rsqrtf(wave_sum(ss) * (1.f / DM) + EPS);
            const float* sh = shift0 + (size_t)grp * 12288; const float* sc = scale0 + (size_t)grp * 12288; bf16* ho = hdst + (size_t)m * DM;
#pragma unroll
            for (int j = 0; j < 8; ++j) { const f32x4 g = *(const f32x4*)(gpre + 4 * lane + 256 * j), s1 = *(const f32x4*)(sc + 4 * lane + 256 * j), s0 = *(const f32x4*)(sh + 4 * lane + 256 * j);
                const f32x4 o = (v[j] * rs * g) * (s1 + 1.f) + s0; *(v2u*)(ho + 4 * lane + 256 * j) = (v2u){pk2(o.x, o.y), pk2(o.z, o.w)}; }
        }
    }
}

__device__ __forceinline__ void phase_hgrn_combine(const Args& a, int gw, int lane, int NGW) {
    const float* ofw = a.out; const float* obw = a.out + (size_t)MT * 1024; const bf16* proj = (const bf16*)(a.ws + WS_P2); bf16* ob = (bf16*)(a.ws + WS_B); const float* hng = a.in[I_HNG];
    const int c0 = lane * 16;
    for (int m = gw; m < MT; m += NGW) {
        f32x4 s[4]; float ss = 0.f;
#pragma unroll
        for (int j = 0; j < 4; ++j) { s[j] = *(const f32x4*)(ofw + (size_t)m * 1024 + c0 + 4 * j) + *(const f32x4*)(obw + (size_t)m * 1024 + c0 + 4 * j); ss += (s[j].x * s[j].x + s[j].y * s[j].y) + (s[j].z * s[j].z + s[j].w * s[j].w); }
        ss += __shfl_xor(ss, 1); ss += __shfl_xor(ss, 2); ss += __shfl_xor(ss, 4);
        const float rs = rsqrtf(ss * (1.f / 128.f) + EPS);
        const v4u g0 = *(const v4u*)(proj + (size_t)m * 4096 + c0), g1 = *(const v4u*)(proj + (size_t)m * 4096 + c0 + 8);
        float gv[16] = {bflo(g0.x), bfhi(g0.x), bflo(g0.y), bfhi(g0.y), bflo(g0.z), bfhi(g0.z), bflo(g0.w), bfhi(g0.w), bflo(g1.x), bfhi(g1.x), bflo(g1.y), bfhi(g1.y), bflo(g1.z), bfhi(g1.z), bflo(g1.w), bfhi(g1.w)};
        float o[16];
#pragma unroll
        for (int j = 0; j < 4; ++j) { const f32x4 gn = *(const f32x4*)(hng + (c0 & 127) + 4 * j);
#pragma unroll
            for (int e = 0; e < 4; ++e) { const float ga = gv[4 * j + e]; o[4 * j + e] = s[j][e] * rs * gn[e] * (ga / (1.f + __expf(-ga))); } }
        v4u w0 = {pk2(o[0], o[1]), pk2(o[2], o[3]), pk2(o[4], o[5]), pk2(o[6], o[7])}, w1 = {pk2(o[8], o[9]), pk2(o[10], o[11]), pk2(o[12], o[13]), pk2(o[14], o[15])};
        *(v4u*)(ob + (size_t)m * 2048 + c0) = w0; *(v4u*)(ob + (size_t)m * 2048 + c0 + 8) = w1;
    }
}

__device__ __forceinline__ void phase_mla_rows(const Args& a, int gw, int lane, int NGW) {
    const float* cqkv = (const float*)(a.ws + WS_C); bf16* cqn = (bf16*)(a.ws + WS_D_CQN); bf16* ckvn = (bf16*)(a.ws + WS_D_CKVN); bf16* krot = (bf16*)(a.ws + WS_D_KROT); const float* rope = (const float*)(a.ws + WS_ROPE);
    const f32x4 gq0 = *(const f32x4*)(a.in[I_QNG] + lane * 8), gq1 = *(const f32x4*)(a.in[I_QNG] + lane * 8 + 4), gk0 = *(const f32x4*)(a.in[I_KVNG] + lane * 8), gk1 = *(const f32x4*)(a.in[I_KVNG] + lane * 8 + 4);
    for (int m = gw; m < MT; m += NGW) {
        const float* r = cqkv + (size_t)m * ODD_PAD;
        { const f32x4 x0 = *(const f32x4*)(r + lane * 8), x1 = *(const f32x4*)(r + lane * 8 + 4);
          const float ss = (x0.x * x0.x + x0.y * x0.y) + (x0.z * x0.z + x0.w * x0.w) + (x1.x * x1.x + x1.y * x1.y) + (x1.z * x1.z + x1.w * x1.w);
          const float rs = rsqrtf(wave_sum(ss) * (1.f / 512.f) + EPS); const f32x4 o0 = x0 * rs * gq0, o1 = x1 * rs * gq1;
          *(v4u*)(cqn + (size_t)m * 512 + lane * 8) = (v4u){pk2(o0.x, o0.y), pk2(o0.z, o0.w), pk2(o1.x, o1.y), pk2(o1.z, o1.w)}; }
        { const f32x4 x0 = *(const f32x4*)(r + 512 + lane * 8), x1 = *(const f32x4*)(r + 512 + lane * 8 + 4);
          const float ss = (x0.x * x0.x + x0.y * x0.y) + (x0.z * x0.z + x0.w * x0.w) + (x1.x * x1.x + x1.y * x1.y) + (x1.z * x1.z + x1.w * x1.w);
          const float rs = rsqrtf(wave_sum(ss) * (1.f / 512.f) + EPS); const f32x4 o0 = x0 * rs * gk0, o1 = x1 * rs * gk1;
          *(v4u*)(ckvn + (size_t)m * 512 + lane * 8) = (v4u){pk2(o0.x, o0.y), pk2(o0.z, o0.w), pk2(o1.x, o1.y), pk2(o1.z, o1.w)};
          if (m < MC) { float* op = a.out + O_CKV + (size_t)m * 512 + lane * 8; *(f32x4*)op = o0; *(f32x4*)(op + 4) = o1; } }
        { const float x = r[1024 + lane];
          if (m < MC) { a.out[O_KPE + (size_t)m * 64 + lane] = x; krot[(size_t)m * 64 + lane] = (bf16)f2bf(x); }
          else { const int pos = (m - MC) & 2047, p = (lane >> 5) ? (pos & 63) : (pos >> 6), j = lane & 31, i16 = j & 15; const float c = rope[p * 32 + i16], s = rope[p * 32 + 16 + i16];
              const float pr = __shfl_xor(x, 16); const float yv = j < 16 ? x * c - pr * s : x * c + pr * s; krot[(size_t)m * 64 + lane] = (bf16)f2bf(yv); } }
    }
    for (int i = gw; i < LBT * PAST; i += NGW) {
        const f32x4 x0 = *(const f32x4*)(a.in[I_CKV] + (size_t)i * 512 + lane * 8), x1 = *(const f32x4*)(a.in[I_CKV] + (size_t)i * 512 + lane * 8 + 4);
        *(v4u*)(ckvn + (size_t)(MT + i) * 512 + lane * 8) = (v4u){pk2(x0.x, x0.y), pk2(x0.z, x0.w), pk2(x1.x, x1.y), pk2(x1.z, x1.w)};
        krot[(size_t)(MT + i) * 64 + lane] = (bf16)f2bf(a.in[I_KPE][(size_t)i * 64 + lane]);
    }
}
namespace hg {
#define KSWZ(row, colB) ((row) * 272 + (colB))
__device__ __forceinline__ int tsw(int row, int sB) { return row * 80 + sB; }
__device__ __forceinline__ int crow(int r, int hi) { return (r & 3) + 8 * (r >> 2) + 4 * hi; }
__device__ __forceinline__ unsigned cvtpk(float lo, float hi) { unsigned r; asm volatile("v_cvt_pk_bf16_f32 %0, %1, %2" : "=v"(r) : "v"(lo), "v"(hi)); return r; }
constexpr int B_QT = 0, B_KT = 8704, B_KTT = 17408, B_VT = 27648, B_SZ = 37888;

#if defined(PROBE_HGWAIT) && PROBE_HGWAIT == 1
#define HG_SYNC_P() do { const unsigned long long t0_ = __builtin_amdgcn_s_memrealtime(); __syncthreads(); wacc += __builtin_amdgcn_s_memrealtime() - t0_; } while (0)
#define HG_SYNC_C() __syncthreads()
#elif defined(PROBE_HGWAIT) && PROBE_HGWAIT == 2
#define HG_SYNC_P() __syncthreads()
#define HG_SYNC_C() do { const unsigned long long t0_ = __builtin_amdgcn_s_memrealtime(); __syncthreads(); wacc += __builtin_amdgcn_s_memrealtime() - t0_; } while (0)
#else
#define HG_SYNC_P() __syncthreads()
#define HG_SYNC_C() __syncthreads()
#endif
__device__ __forceinline__ void hgrn_item(LAS unsigned char* lds, const Args& a, int type, int item, int tid, unsigned long long& wacc) {
    asm volatile("" : "+v"(tid));
    const int wid = __builtin_amdgcn_readfirstlane(tid >> 6), lane = tid & 63, r32 = lane & 31, hi = lane >> 5;
    const int b = item >> 4, h = (item >> 1) & 7, dir = item & 1;
    const int T = type ? LT : CT, mbase = type ? MC + b * LT : b * CT, NC = T / 32;
    LAS float* Dl0 = (LAS float*)(lds + LDSCTL_OFF + 1024);
    __syncthreads();
    if (wid >= 4) {
        const unsigned char* hgb = (const unsigned char*)(a.ws + WS_SCAN) + ((size_t)mbase * 8 + (size_t)h * T) * 1536;
        const int fo = dir ? 1024 : 512;
        const int t256 = tid & 255, k = t256 & 127, th = __builtin_amdgcn_readfirstlane(t256 >> 7);
        const int ts = t256 >> 3, c16 = (t256 & 7) * 16, vs = t256 & 31, vc = (t256 >> 5) * 8;
        LAS unsigned char* RF = lds + 2 * B_SZ; LAS unsigned char* RQ = RF + 32 * 528;
        v4u fA[4], qA[2], vA[2], fB[4], qB[2], vB[2];
#define HLOAD(c_, fr, qr_, vr) do { { const int p_ = (c_) * 32 + ts; const int t_ = dir ? T - 1 - p_ : p_; const unsigned char* rp_ = hgb + t_ * 1536; \
            fr[0] = *(const v4u*)(rp_ + fo + c16 * 4); fr[1] = *(const v4u*)(rp_ + fo + c16 * 4 + 16); fr[2] = *(const v4u*)(rp_ + fo + c16 * 4 + 32); fr[3] = *(const v4u*)(rp_ + fo + c16 * 4 + 48); \
            qr_[0] = *(const v4u*)(rp_ + c16 * 2); qr_[1] = *(const v4u*)(rp_ + c16 * 2 + 16); } \
        { const int p_ = (c_) * 32 + vs; const int t_ = dir ? T - 1 - p_ : p_; const unsigned char* rp_ = hgb + t_ * 1536 + 256 + 2 * vc; vr[0] = *(const v4u*)rp_; vr[1] = *(const v4u*)(rp_ + 128); } } while (0)
#define HSTAGE(bufi_, fr, qr_, vr) do { LAS unsigned char* B_ = lds + (bufi_) * B_SZ; \
        *(LAS v4u*)(RF + ts * 528 + c16 * 4) = fr[0]; *(LAS v4u*)(RF + ts * 528 + c16 * 4 + 16) = fr[1]; *(LAS v4u*)(RF + ts * 528 + c16 * 4 + 32) = fr[2]; *(LAS v4u*)(RF + ts * 528 + c16 * 4 + 48) = fr[3]; \
        *(LAS v4u*)(RQ + ts * 272 + c16 * 2) = qr_[0]; *(LAS v4u*)(RQ + ts * 272 + c16 * 2 + 16) = qr_[1]; \
        _Pragma("unroll") for (int ps_ = 0; ps_ < 2; ++ps_) { const v4u x_ = vr[ps_]; const int c_ = vc + 64 * ps_; \
            *(LAS unsigned short*)(B_ + B_VT + tsw(c_ + 0, 2 * vs)) = (unsigned short)(x_.x & 0xffffu); *(LAS unsigned short*)(B_ + B_VT + tsw(c_ + 1, 2 * vs)) = (unsigned short)(x_.x >> 16); \
            *(LAS unsigned short*)(B_ + B_VT + tsw(c_ + 2, 2 * vs)) = (unsigned short)(x_.y & 0xffffu); *(LAS unsigned short*)(B_ + B_VT + tsw(c_ + 3, 2 * vs)) = (unsigned short)(x_.y >> 16); \
            *(LAS unsigned short*)(B_ + B_VT + tsw(c_ + 4, 2 * vs)) = (unsigned short)(x_.z & 0xffffu); *(LAS unsigned short*)(B_ + B_VT + tsw(c_ + 5, 2 * vs)) = (unsigned short)(x_.z >> 16); \
            *(LAS unsigned short*)(B_ + B_VT + tsw(c_ + 6, 2 * vs)) = (unsigned short)(x_.w & 0xffffu); *(LAS unsigned short*)(B_ + B_VT + tsw(c_ + 7, 2 * vs)) = (unsigned short)(x_.w >> 16); } } while (0)
#define HPREP(bufi_) do { LAS unsigned char* B_ = lds + (bufi_) * B_SZ; float cp_ = 1.f; \
        if (th) { _Pragma("unroll") for (int i_ = 0; i_ < 16; ++i_) cp_ *= *(const LAS float*)(RF + i_ * 528 + 4 * k); } \
        unsigned kw_[8]; unsigned klo_ = 0u; \
        _Pragma("unroll") for (int i_ = 0; i_ < 16; ++i_) { const int s_ = 16 * th + i_; const float f_ = *(const LAS float*)(RF + s_ * 528 + 4 * k); cp_ *= f_; const float cc_ = fmaxf(cp_, 1e-30f); \
            const float qt_ = bf2f(*(const LAS unsigned short*)(RQ + s_ * 272 + 2 * k)) * cc_, kt_ = (1.f - f_) * __builtin_amdgcn_rcpf(cc_); const unsigned w_ = cvtpk(qt_, kt_); \
            *(LAS unsigned short*)(B_ + B_QT + KSWZ(s_, 2 * k)) = (unsigned short)(w_ & 0xffffu); *(LAS unsigned short*)(B_ + B_KT + KSWZ(s_, 2 * k)) = (unsigned short)(w_ >> 16); \
            if (i_ & 1) kw_[i_ >> 1] = klo_ | (w_ & 0xffff0000u); else klo_ = w_ >> 16; } \
        *(LAS v4u*)(B_ + B_KTT + tsw(k, 32 * th)) = (v4u){kw_[0], kw_[1], kw_[2], kw_[3]}; *(LAS v4u*)(B_ + B_KTT + tsw(k, 32 * th + 16)) = (v4u){kw_[4], kw_[5], kw_[6], kw_[7]}; \
        if (th) Dl0[(bufi_) * 128 + k] = fmaxf(cp_, 1e-30f); } while (0)
        HLOAD(0, fA, qA, vA); HLOAD(1, fB, qB, vB); HSTAGE(0, fA, qA, vA); HLOAD(2, fA, qA, vA);
        __syncthreads();
        HPREP(0);
        __syncthreads();
        for (int n = 0; n < NC; n += 2) {
            HSTAGE(1, fB, qB, vB); { const int c3 = n + 3 < NC ? n + 3 : NC - 1; HLOAD(c3, fB, qB, vB); }
            HG_SYNC_P();
            HPREP(1);
            HG_SYNC_P();
            HSTAGE(0, fA, qA, vA); { const int c4 = n + 4 < NC ? n + 4 : NC - 1; HLOAD(c4, fA, qA, vA); }
            HG_SYNC_P();
            HPREP(0);
            HG_SYNC_P();
        }
#undef HLOAD
#undef HSTAGE
#undef HPREP
    } else {
        const int w4 = wid;
        f32x16 S[4];
        if (type) { const float* sp = (dir ? a.in[I_SB] : a.in[I_SF]) + (size_t)(b * 8 + h) * 16384 + 32 * w4 + r32;
#pragma unroll
            for (int kt = 0; kt < 4; ++kt)
#pragma unroll
                for (int r = 0; r < 16; ++r) S[kt][r] = sp[(32 * kt + crow(r, hi)) * 128]; }
        else {
#pragma unroll
            for (int kt = 0; kt < 4; ++kt) S[kt] = (f32x16){}; }
        float* odir = a.out + (dir ? (size_t)MT * 1024 : 0) + h * 128 + 32 * w4 + r32;
        __syncthreads();
        __syncthreads();
        for (int n = 0; n < NC; ++n) {
            HG_SYNC_C();
            const LAS unsigned char* Bf = lds + (n & 1) * B_SZ; const LAS float* Dl = Dl0 + (n & 1) * 128;
            f32x16 O = {};
            { bf16x8 qa[8];
#pragma unroll
              for (int i = 0; i < 8; ++i) { const int cb = (32 * (i >> 1) + 16 * (i & 1)) * 2 + 8 * hi;
                  const s16x4 q0 = *(const LAS s16x4*)(Bf + B_QT + KSWZ(r32, cb)), q1 = *(const LAS s16x4*)(Bf + B_QT + KSWZ(r32, cb + 16));
                  qa[i] = (bf16x8){q0[0], q0[1], q0[2], q0[3], q1[0], q1[1], q1[2], q1[3]}; }
#pragma unroll
              for (int i = 0; i < 8; ++i) { const int kt = i >> 1, st = i & 1;
                  v4u w; w.x = cvtpk(S[kt][8 * st + 0], S[kt][8 * st + 1]); w.y = cvtpk(S[kt][8 * st + 2], S[kt][8 * st + 3]); w.z = cvtpk(S[kt][8 * st + 4], S[kt][8 * st + 5]); w.w = cvtpk(S[kt][8 * st + 6], S[kt][8 * st + 7]);
                  O = __builtin_amdgcn_mfma_f32_32x32x16_bf16(qa[i], __builtin_bit_cast(bf16x8, w), O, 0, 0, 0); } }
            f32x16 X = {};
            { bf16x8 ka[8], qb[8];
#pragma unroll
              for (int d0 = 0; d0 < 8; ++d0) { const int cb = (d0 * 16 + hi * 8) * 2; ka[d0] = *(const LAS bf16x8*)(Bf + B_KT + KSWZ(r32, cb)); qb[d0] = *(const LAS bf16x8*)(Bf + B_QT + KSWZ(r32, cb)); }
#pragma unroll
              for (int d0 = 0; d0 < 8; ++d0) X = __builtin_amdgcn_mfma_f32_32x32x16_bf16(ka[d0], qb[d0], X, 0, 0, 0); }
            bf16x8 vperm[2], vnat[2], ktt[8]; f32x4 dv[16];
#pragma unroll
            for (int st = 0; st < 2; ++st) { const int vrow = 32 * w4 + r32;
                const s16x4 v0 = *(const LAS s16x4*)(Bf + B_VT + tsw(vrow, 32 * st + 8 * hi)), v1 = *(const LAS s16x4*)(Bf + B_VT + tsw(vrow, 32 * st + 8 * hi + 16));
                vperm[st] = (bf16x8){v0[0], v0[1], v0[2], v0[3], v1[0], v1[1], v1[2], v1[3]};
                vnat[st] = *(const LAS bf16x8*)(Bf + B_VT + tsw(vrow, 32 * st + 16 * hi)); }
#pragma unroll
            for (int i = 0; i < 8; ++i) ktt[i] = *(const LAS bf16x8*)(Bf + B_KTT + tsw(32 * (i & 3) + r32, 32 * (i >> 2) + 16 * hi));
#pragma unroll
            for (int i = 0; i < 16; ++i) dv[i] = *(const LAS f32x4*)(Dl + 32 * (i >> 2) + 8 * (i & 3) + 4 * hi);
#pragma unroll
            for (int r = 0; r < 16; ++r) X[r] = (crow(r, hi) <= r32) ? X[r] : 0.f;
#pragma unroll
            for (int st = 0; st < 2; ++st) {
                v4u w; w.x = cvtpk(X[8 * st + 0], X[8 * st + 1]); w.y = cvtpk(X[8 * st + 2], X[8 * st + 3]); w.z = cvtpk(X[8 * st + 4], X[8 * st + 5]); w.w = cvtpk(X[8 * st + 6], X[8 * st + 7]);
                O = __builtin_amdgcn_mfma_f32_32x32x16_bf16(__builtin_bit_cast(bf16x8, w), vperm[st], O, 0, 0, 0);
            }
#pragma unroll
            for (int st = 0; st < 2; ++st)
#pragma unroll
                for (int kt = 0; kt < 4; ++kt) S[kt] = __builtin_amdgcn_mfma_f32_32x32x16_bf16(ktt[st * 4 + kt], vnat[st], S[kt], 0, 0, 0);
#pragma unroll
            for (int r = 0; r < 16; ++r) { const int p = n * 32 + crow(r, hi), t = dir ? T - 1 - p : p; odir[(size_t)(mbase + t) * 1024] = O[r]; }
#pragma unroll
            for (int kt = 0; kt < 4; ++kt)
#pragma unroll
                for (int g = 0; g < 4; ++g) { const f32x4 x = dv[kt * 4 + g]; S[kt][4 * g] *= x.x; S[kt][4 * g + 1] *= x.y; S[kt][4 * g + 2] *= x.z; S[kt][4 * g + 3] *= x.w; }
            HG_SYNC_C();
        }
        if (!type) { float* sp = a.out + (dir ? O_SB : O_SF) + (size_t)(b * 8 + h) * 16384 + 32 * w4 + r32;
#pragma unroll
            for (int kt = 0; kt < 4; ++kt)
#pragma unroll
                for (int r = 0; r < 16; ++r) sp[(32 * kt + crow(r, hi)) * 128] = S[kt][r]; }
    }
}
#undef KSWZ
}

namespace att {
#define KSWZ(row, colB) ((row) * 256 + ((colB) ^ (((row) & 7) << 4)))
#define RSWZ(row, colB) ((row) * 128 + ((colB) ^ (((row) & 7) << 4)))
#define SBAR() __builtin_amdgcn_sched_barrier(0)
constexpr int L_V = 0, L_K = 32768, L_R = 65536, L_WS = 81920, L_QR = 83968;
constexpr float THRL = 11.5f;
__device__ __forceinline__ int crow(int r, int hi) { return (r & 3) + 8 * (r >> 2) + 4 * hi; }
__device__ __forceinline__ unsigned cvtpk(float lo, float hi) { unsigned r; asm volatile("v_cvt_pk_bf16_f32 %0, %1, %2" : "=v"(r) : "v"(lo), "v"(hi)); return r; }
__device__ __forceinline__ int v_st(int k, int c) { const int kk = (k & ~0xC) | ((k & 4) << 1) | ((k & 8) >> 1); return ((kk >> 3) * 4 + (c >> 5)) * 512 + ((kk & 7) * 32 + (c & 31)) * 2; }
__device__ __forceinline__ int v_rd_base(int lane) { return ((lane & 3) << 3) | (((lane >> 2) & 3) << 6) | (((lane >> 4) & 1) << 5) | (((lane >> 5) & 1) << 8); }
constexpr int v_rd_off(int d0, int ks, int half) { return d0 * 512 + ks * 4096 + half * 2048; }
template <int OFF> __device__ __forceinline__ s16x4 tr_read(int vb) { s16x4 r; asm volatile("ds_read_b64_tr_b16 %0, %1 offset:%2" : "=&v"(r) : "v"(vb), "i"(OFF) : "memory"); return r; }
template <int D0> __device__ __forceinline__ void pv_one(f32x16& od, int vb, bf16x8 pa0, bf16x8 pa1, bf16x8 pa2, bf16x8 pa3) {
    const s16x4 l0 = tr_read<v_rd_off(D0, 0, 0)>(vb), h0 = tr_read<v_rd_off(D0, 0, 1)>(vb), l1 = tr_read<v_rd_off(D0, 1, 0)>(vb), h1 = tr_read<v_rd_off(D0, 1, 1)>(vb);
    const s16x4 l2 = tr_read<v_rd_off(D0, 2, 0)>(vb), h2 = tr_read<v_rd_off(D0, 2, 1)>(vb), l3 = tr_read<v_rd_off(D0, 3, 0)>(vb), h3 = tr_read<v_rd_off(D0, 3, 1)>(vb);
    asm volatile("s_waitcnt lgkmcnt(0)" ::: "memory"); SBAR();
#define PK(L, H) (bf16x8){L[0], L[1], L[2], L[3], H[0], H[1], H[2], H[3]}
    od = __builtin_amdgcn_mfma_f32_32x32x16_bf16(pa0, PK(l0, h0), od, 0, 0, 0);
    od = __builtin_amdgcn_mfma_f32_32x32x16_bf16(pa1, PK(l1, h1), od, 0, 0, 0);
    od = __builtin_amdgcn_mfma_f32_32x32x16_bf16(pa2, PK(l2, h2), od, 0, 0, 0);
    od = __builtin_amdgcn_mfma_f32_32x32x16_bf16(pa3, PK(l3, h3), od, 0, 0, 0);
#undef PK
}
struct Seg { const bf16* K; const bf16* V; const bf16* R; int ldk; int nt; };
struct Unit {
    const bf16* Q; int ldq; bf16* O; int ldo; Seg s0, s1;
    const float* rope; int pos0;
    const float* bias; int r0, rs;
    float C;
};
__device__ __forceinline__ bf16x8 ld8(const bf16* p) { return *(const bf16x8*)p; }

template <int DQK, bool NA>
__device__ __forceinline__ void attn_unit(LAS unsigned char* lds, const Unit& U, int tid) {
    asm volatile("" : "+v"(tid));
    const int wid = __builtin_amdgcn_readfirstlane(tid >> 6), lane = tid & 63, r32 = lane & 31, hi = lane >> 5;
    LAS float* wsl = (LAS float*)(lds + L_WS) + wid * 64; LAS float* li_l = wsl; LAS float* al_l = wsl + 32;
    float m_reg = -1e30f, l_reg = 0.f; f32x16 o[4] = {}; bf16x8 qr[8];
    const bf16* Qw = U.Q + (size_t)(wid * 32 + r32) * U.ldq + hi * 8;
#pragma unroll
    for (int d0 = 0; d0 < 8; ++d0) qr[d0] = ld8(Qw + d0 * 16);
    if constexpr (DQK == 192) {
        bf16x8 e0 = ld8(Qw + 128), e1 = ld8(Qw + 144), e2 = ld8(Qw + 160), e3 = ld8(Qw + 176);
        LAS unsigned char* qrl = lds + L_QR + wid * 8192 + lane * 16;
        *(LAS bf16x8*)(qrl + 4096) = e0; *(LAS bf16x8*)(qrl + 5120) = e1; *(LAS bf16x8*)(qrl + 6144) = e2; *(LAS bf16x8*)(qrl + 7168) = e3;
        if (U.rope) { const int pos = U.pos0 + wid * 32 + r32; const float* tr = U.rope + (pos >> 6) * 32 + hi * 8; const float* tc = U.rope + (pos & 63) * 32 + hi * 8;
            unsigned short a0[8], a1[8], a2[8], a3[8];
#pragma unroll
            for (int j = 0; j < 8; ++j) { float c = tr[j], s = tr[16 + j]; float x1 = bf2f((unsigned short)e0[j]), x2 = bf2f((unsigned short)e1[j]); a0[j] = (unsigned short)f2bf(x1 * c - x2 * s); a1[j] = (unsigned short)f2bf(x2 * c + x1 * s);
                c = tc[j]; s = tc[16 + j]; x1 = bf2f((unsigned short)e2[j]); x2 = bf2f((unsigned short)e3[j]); a2[j] = (unsigned short)f2bf(x1 * c - x2 * s); a3[j] = (unsigned short)f2bf(x2 * c + x1 * s); }
#pragma unroll
            for (int j = 0; j < 8; ++j) { e0[j] = (short)a0[j]; e1[j] = (short)a1[j]; e2[j] = (short)a2[j]; e3[j] = (short)a3[j]; } }
        *(LAS bf16x8*)(qrl) = e0; *(LAS bf16x8*)(qrl + 1024) = e1; *(LAS bf16x8*)(qrl + 2048) = e2; *(LAS bf16x8*)(qrl + 3072) = e3;
    }
    const int sr = tid >> 4, sc = (tid & 15) * 8, vst0 = v_st(sr, sc), vst1 = v_st(32 + sr, sc), rr = tid >> 3, rc = (tid & 7) * 8;
    const int vb0 = (int)(unsigned)(uintptr_t)(lds + L_V) + v_rd_base(lane);
    const int nt0 = U.s0.nt, NT = U.s0.nt + U.s1.nt;
    bf16x8 sv0, sv1, sk0, sk1, srp;
#define SLOAD(j_) do { const bool f_ = (j_) < nt0; const bf16* K_ = f_ ? U.s0.K : U.s1.K; const bf16* V_ = f_ ? U.s0.V : U.s1.V; const int ld_ = f_ ? U.s0.ldk : U.s1.ldk; const int k0_ = (f_ ? (j_) : (j_) - nt0) * 64; \
        const unsigned e0_ = (unsigned)((k0_ + sr) * ld_ + sc), e1_ = e0_ + 32u * (unsigned)ld_; \
        sv0 = ld8(V_ + e0_); sv1 = ld8(V_ + e1_); sk0 = ld8(K_ + e0_); sk1 = ld8(K_ + e1_); \
        if constexpr (DQK == 192) { const bf16* R_ = f_ ? U.s0.R : U.s1.R; srp = ld8(R_ + (unsigned)((k0_ + rr) * 64 + rc)); } } while (0)
#define SWRITE(b_) do { *(LAS bf16x8*)(lds + L_V + (b_) * 16384 + vst0) = sv0; *(LAS bf16x8*)(lds + L_V + (b_) * 16384 + vst1) = sv1; \
        *(LAS bf16x8*)(lds + L_K + (b_) * 16384 + KSWZ(sr, sc * 2)) = sk0; *(LAS bf16x8*)(lds + L_K + (b_) * 16384 + KSWZ(32 + sr, sc * 2)) = sk1; \
        if constexpr (DQK == 192) *(LAS bf16x8*)(lds + L_R + (b_) * 8192 + RSWZ(rr, rc * 2)) = srp; } while (0)
    SLOAD(0); VM_WAIT(); SWRITE(0); __syncthreads();
    const float C = U.C;
    for (int j = 0; j < NT; ++j) {
        const int b = j & 1;
        bool valid = true; int dr = 15; const bool lat = NA && j < nt0;
        if (lat) { const int kr = U.rs + j, qrow = U.r0 + (wid >> 1); int w0 = qrow - 4; w0 = w0 < 0 ? 0 : (w0 > 24 ? 24 : w0); valid = kr >= w0 && kr < w0 + 8; dr = valid ? kr - qrow + 7 : 15; }
        f32x16 p0 = {}, p1 = {};
        if constexpr (NA) {
            const float* bp = U.bias + (unsigned)((dr * 64 + 32 * (wid & 1) + r32) * 64 + 4 * hi);
#pragma unroll
            for (int g = 0; g < 4; ++g) { const f32x4 x = *(const f32x4*)(bp + 8 * g), y = *(const f32x4*)(bp + 32 + 8 * g);
                p0[4 * g] = x.x; p0[4 * g + 1] = x.y; p0[4 * g + 2] = x.z; p0[4 * g + 3] = x.w; p1[4 * g] = y.x; p1[4 * g + 1] = y.y; p1[4 * g + 2] = y.z; p1[4 * g + 3] = y.w; } }
        { const int jn = j + 1 < NT ? j + 1 : NT - 1; SLOAD(jn); }
        if (valid) {
            { const LAS unsigned char* Ks = lds + L_K + b * 16384;
#pragma unroll
              for (int d0 = 0; d0 < 8; ++d0) { const int cb = (d0 * 16 + hi * 8) * 2;
                  const bf16x8 b0 = *(const LAS bf16x8*)(Ks + KSWZ(r32, cb)), b1 = *(const LAS bf16x8*)(Ks + KSWZ(32 + r32, cb));
                  p0 = __builtin_amdgcn_mfma_f32_32x32x16_bf16(b0, qr[d0], p0, 0, 0, 0); p1 = __builtin_amdgcn_mfma_f32_32x32x16_bf16(b1, qr[d0], p1, 0, 0, 0);
                  if (d0 == 3) SBAR(); }
              if constexpr (DQK == 192) { const LAS unsigned char* Rs = lds + L_R + b * 8192;
                  const LAS unsigned char* qv = lds + L_QR + wid * 8192 + lane * 16 + ((U.rope && j >= nt0) ? 4096 : 0);
#pragma unroll
                  for (int d0 = 0; d0 < 4; ++d0) { const int cb = (d0 * 16 + hi * 8) * 2;
                      const bf16x8 b0 = *(const LAS bf16x8*)(Rs + RSWZ(r32, cb)), b1 = *(const LAS bf16x8*)(Rs + RSWZ(32 + r32, cb)), qf = *(const LAS bf16x8*)(qv + d0 * 1024);
                      p0 = __builtin_amdgcn_mfma_f32_32x32x16_bf16(b0, qf, p0, 0, 0, 0); p1 = __builtin_amdgcn_mfma_f32_32x32x16_bf16(b1, qf, p1, 0, 0, 0); } } }
#pragma unroll
            for (int r = 0; r < 16; ++r) { p0[r] *= C; p1[r] *= C; }
            float pmax = p0[0];
#pragma unroll
            for (int r = 1; r < 16; ++r) pmax = fmaxf(pmax, p0[r]);
#pragma unroll
            for (int r = 0; r < 16; ++r) pmax = fmaxf(pmax, p1[r]);
            { auto x = __builtin_amdgcn_permlane32_swap(__float_as_uint(pmax), __float_as_uint(pmax), false, false); pmax = fmaxf(__uint_as_float(x[0]), __uint_as_float(x[1])); }
            float alpha = 1.f;
            if (!__all(pmax - m_reg <= THRL)) { const float mn = fmaxf(m_reg, pmax); alpha = __builtin_amdgcn_exp2f(m_reg - mn); m_reg = mn; }
            float ps = 0.f;
#pragma unroll
            for (int r = 0; r < 16; ++r) { p0[r] = __builtin_amdgcn_exp2f(p0[r] - m_reg); p1[r] = __builtin_amdgcn_exp2f(p1[r] - m_reg); ps += p0[r] + p1[r]; }
            { auto x = __builtin_amdgcn_permlane32_swap(__float_as_uint(ps), __float_as_uint(ps), false, false); ps = __uint_as_float(x[0]) + __uint_as_float(x[1]); }
            l_reg = l_reg * alpha + ps;
            bf16x8 pa0, pa1, pa2, pa3;
#define PK4(P, BASE, OUT) do { unsigned a0 = cvtpk(P[BASE + 0], P[BASE + 1]), a1 = cvtpk(P[BASE + 2], P[BASE + 3]); unsigned b0 = cvtpk(P[BASE + 4], P[BASE + 5]), b1 = cvtpk(P[BASE + 6], P[BASE + 7]); \
        auto r0 = __builtin_amdgcn_permlane32_swap(a0, b0, false, false); auto r1 = __builtin_amdgcn_permlane32_swap(a1, b1, false, false); \
        v4u w = {r0[0], r1[0], r0[1], r1[1]}; OUT = __builtin_bit_cast(bf16x8, w); } while (0)
            PK4(p0, 0, pa0); PK4(p0, 8, pa1); PK4(p1, 0, pa2); PK4(p1, 8, pa3);
#undef PK4
            if (__any(alpha < 1.f)) { if (hi == 0) al_l[r32] = alpha; LDS_WAIT();
#pragma unroll
                for (int r = 0; r < 16; ++r) { const float av = al_l[crow(r, hi)];
#pragma unroll
                    for (int d = 0; d < 4; ++d) o[d][r] *= av; } }
            const int vb = vb0 + b * 16384;
            pv_one<0>(o[0], vb, pa0, pa1, pa2, pa3); pv_one<1>(o[1], vb, pa0, pa1, pa2, pa3); pv_one<2>(o[2], vb, pa0, pa1, pa2, pa3); pv_one<3>(o[3], vb, pa0, pa1, pa2, pa3);
        }
        VM_WAIT(); SWRITE(b ^ 1);
        __syncthreads();
    }
#undef SLOAD
#undef SWRITE
    if (hi == 0) li_l[r32] = l_reg;
    LDS_WAIT();
    bf16* Ow = U.O + (size_t)(wid * 32) * U.ldo;
#pragma unroll
    for (int r = 0; r < 16; ++r) { const int orow = crow(r, hi); const float rl = 1.f / li_l[orow];
#pragma unroll
        for (int d0 = 0; d0 < 4; ++d0) Ow[(size_t)orow * U.ldo + d0 * 32 + r32] = (bf16)f2bf(o[d0][r] * rl); }
}

constexpr float MLA_SCALE = 0.07216878364870322f, MLA_C = MLA_SCALE * LOG2E, MLA_THR = 8.f;
__device__ __forceinline__ void m_partialSM(f32x16& p0, f32x16& p1, float& m_reg, float& mn, float& alpha) {
    float pmax = p0[0];
#pragma unroll
    for (int r = 1; r < 16; ++r) pmax = fmaxf(pmax, p0[r]);
#pragma unroll
    for (int r = 0; r < 16; ++r) pmax = fmaxf(pmax, p1[r]);
    { auto rr = __builtin_amdgcn_permlane32_swap(__float_as_uint(pmax), __float_as_uint(pmax), false, false); pmax = fmaxf(__uint_as_float(rr[0]), __uint_as_float(rr[1])); }
    if (__builtin_expect(__all(pmax - m_reg <= MLA_THR / MLA_SCALE), 1)) { mn = m_reg; alpha = 1.f; }
    else { mn = fmaxf(m_reg, pmax); alpha = __builtin_amdgcn_exp2f((m_reg - mn) * MLA_C); m_reg = mn; }
    const float mnC = -mn * MLA_C;
#pragma unroll
    for (int r = 0; r < 16; ++r) p0[r] = fmaf(p0[r], MLA_C, mnC);
#pragma unroll
    for (int r = 0; r < 16; ++r) p1[r] = fmaf(p1[r], MLA_C, mnC);
#pragma unroll
    for (int r = 0; r < 16; ++r) p0[r] = __builtin_amdgcn_exp2f(p0[r]);
}
__device__ __forceinline__ void m_finishSM(f32x16& p0, f32x16& p1, float alpha, float& l_reg, bf16x8& pa0, bf16x8& pa1, bf16x8& pa2, bf16x8& pa3) {
#pragma unroll
    for (int r = 0; r < 16; ++r) p1[r] = __builtin_amdgcn_exp2f(p1[r]);
    float ps = 0.f;
#pragma unroll
    for (int r = 0; r < 16; ++r) ps += p0[r];
#pragma unroll
    for (int r = 0; r < 16; ++r) ps += p1[r];
    { auto rr = __builtin_amdgcn_permlane32_swap(__float_as_uint(ps), __float_as_uint(ps), false, false); ps = __uint_as_float(rr[0]) + __uint_as_float(rr[1]); }
    l_reg = l_reg * alpha + ps;
#define PK4(P, BASE, OUT) do { unsigned a0 = cvtpk(P[BASE + 0], P[BASE + 1]), a1 = cvtpk(P[BASE + 2], P[BASE + 3]); unsigned b0 = cvtpk(P[BASE + 4], P[BASE + 5]), b1 = cvtpk(P[BASE + 6], P[BASE + 7]); \
        auto r0 = __builtin_amdgcn_permlane32_swap(a0, b0, false, false); auto r1 = __builtin_amdgcn_permlane32_swap(a1, b1, false, false); \
        v4u w = {r0[0], r1[0], r0[1], r1[1]}; OUT = __builtin_bit_cast(bf16x8, w); } while (0)
    PK4(p0, 0, pa0); PK4(p0, 8, pa1); PK4(p1, 0, pa2); PK4(p1, 8, pa3);
#undef PK4
}
__device__ __forceinline__ void m_qkt(f32x16& p0, f32x16& p1, const LAS unsigned char* Ks, const LAS unsigned char* Rs, const LAS unsigned char* qv, const bf16x8* qr, int r32, int hi) {
    p0 = f32x16{}; p1 = f32x16{};
#pragma unroll
    for (int d0 = 0; d0 < 8; ++d0) { const int cb = (d0 * 16 + hi * 8) * 2;
        const bf16x8 b0 = *(const LAS bf16x8*)(Ks + KSWZ(r32, cb)), b1 = *(const LAS bf16x8*)(Ks + KSWZ(32 + r32, cb));
        p0 = __builtin_amdgcn_mfma_f32_32x32x16_bf16(b0, qr[d0], p0, 0, 0, 0); p1 = __builtin_amdgcn_mfma_f32_32x32x16_bf16(b1, qr[d0], p1, 0, 0, 0); }
#pragma unroll
    for (int d0 = 0; d0 < 4; ++d0) { const int cb = (d0 * 16 + hi * 8) * 2;
        const bf16x8 b0 = *(const LAS bf16x8*)(Rs + RSWZ(r32, cb)), b1 = *(const LAS bf16x8*)(Rs + RSWZ(32 + r32, cb)), qf = *(const LAS bf16x8*)(qv + d0 * 1024);
        p0 = __builtin_amdgcn_mfma_f32_32x32x16_bf16(b0, qf, p0, 0, 0, 0); p1 = __builtin_amdgcn_mfma_f32_32x32x16_bf16(b1, qf, p1, 0, 0, 0); }
}
__device__ __forceinline__ void m_pv(f32x16* o, int vb, bf16x8 pa0, bf16x8 pa1, bf16x8 pa2, bf16x8 pa3) {
    pv_one<0>(o[0], vb, pa0, pa1, pa2, pa3); pv_one<1>(o[1], vb, pa0, pa1, pa2, pa3); pv_one<2>(o[2], vb, pa0, pa1, pa2, pa3); pv_one<3>(o[3], vb, pa0, pa1, pa2, pa3);
}
__device__ __forceinline__ void attn_mla_unit(LAS unsigned char* lds, const Unit& U, int tid) {
    asm volatile("" : "+v"(tid));
    const int wid = __builtin_amdgcn_readfirstlane(tid >> 6), lane = tid & 63, r32 = lane & 31, hi = lane >> 5;
    LAS float* wsl = (LAS float*)(lds + L_WS) + wid * 64; LAS float* li_l = wsl; LAS float* al_l = wsl + 32;
    float m_reg = -1e30f, l_reg = 0.f; f32x16 o[4] = {}; bf16x8 qr[8];
    const bf16* Qw = U.Q + (size_t)(wid * 32 + r32) * U.ldq + hi * 8;
#pragma unroll
    for (int d0 = 0; d0 < 8; ++d0) qr[d0] = ld8(Qw + d0 * 16);
    LAS unsigned char* qrl = lds + L_QR + wid * 8192 + lane * 16;
    {
        bf16x8 e0 = ld8(Qw + 128), e1 = ld8(Qw + 144), e2 = ld8(Qw + 160), e3 = ld8(Qw + 176);
        *(LAS bf16x8*)(qrl + 4096) = e0; *(LAS bf16x8*)(qrl + 5120) = e1; *(LAS bf16x8*)(qrl + 6144) = e2; *(LAS bf16x8*)(qrl + 7168) = e3;
        if (U.rope) { const int pos = U.pos0 + wid * 32 + r32; const float* tr = U.rope + (pos >> 6) * 32 + hi * 8; const float* tc = U.rope + (pos & 63) * 32 + hi * 8;
            unsigned short a0[8], a1[8], a2[8], a3[8];
#pragma unroll
            for (int j = 0; j < 8; ++j) { float c = tr[j], s = tr[16 + j]; float x1 = bf2f((unsigned short)e0[j]), x2 = bf2f((unsigned short)e1[j]); a0[j] = (unsigned short)f2bf(x1 * c - x2 * s); a1[j] = (unsigned short)f2bf(x2 * c + x1 * s);
                c = tc[j]; s = tc[16 + j]; x1 = bf2f((unsigned short)e2[j]); x2 = bf2f((unsigned short)e3[j]); a2[j] = (unsigned short)f2bf(x1 * c - x2 * s); a3[j] = (unsigned short)f2bf(x2 * c + x1 * s); }
#pragma unroll
            for (int j = 0; j < 8; ++j) { e0[j] = (short)a0[j]; e1[j] = (short)a1[j]; e2[j] = (short)a2[j]; e3[j] = (short)a3[j]; } }
        *(LAS bf16x8*)(qrl) = e0; *(LAS bf16x8*)(qrl + 1024) = e1; *(LAS bf16x8*)(qrl + 2048) = e2; *(LAS bf16x8*)(qrl + 3072) = e3;
    }
    const int sr = tid >> 4, sc = (tid & 15) * 8, vst0 = v_st(sr, sc), vst1 = v_st(32 + sr, sc), rr = tid >> 3, rc = (tid & 7) * 8;
    const int vb0 = (int)(unsigned)(uintptr_t)(lds + L_V) + v_rd_base(lane);
    const int nt0 = U.s0.nt, NT = U.s0.nt + U.s1.nt;
    const bool rot = U.rope != nullptr;
    bf16x8 sv0, sv1, sk0, sk1, srp;
#define SLOAD(j_) do { const bool f_ = (j_) < nt0; const bf16* K_ = f_ ? U.s0.K : U.s1.K; const bf16* V_ = f_ ? U.s0.V : U.s1.V; const bf16* R_ = f_ ? U.s0.R : U.s1.R; const int ld_ = f_ ? U.s0.ldk : U.s1.ldk; const int k0_ = (f_ ? (j_) : (j_) - nt0) * 64; \
        const unsigned e0_ = (unsigned)((k0_ + sr) * ld_ + sc), e1_ = e0_ + 32u * (unsigned)ld_; \
        sv0 = ld8(V_ + e0_); sv1 = ld8(V_ + e1_); sk0 = ld8(K_ + e0_); sk1 = ld8(K_ + e1_); srp = ld8(R_ + (unsigned)((k0_ + rr) * 64 + rc)); } while (0)
#define SWRITE(b_) do { *(LAS bf16x8*)(lds + L_V + (b_) * 16384 + vst0) = sv0; *(LAS bf16x8*)(lds + L_V + (b_) * 16384 + vst1) = sv1; \
        *(LAS bf16x8*)(lds + L_K + (b_) * 16384 + KSWZ(sr, sc * 2)) = sk0; *(LAS bf16x8*)(lds + L_K + (b_) * 16384 + KSWZ(32 + sr, sc * 2)) = sk1; \
        *(LAS bf16x8*)(lds + L_R + (b_) * 8192 + RSWZ(rr, rc * 2)) = srp; } while (0)
#define QV(t_) (lds + L_QR + wid * 8192 + lane * 16 + ((rot && (t_) >= nt0) ? 4096 : 0))
#define RESC(a_) do { if (__any((a_) < 1.f)) { if (hi == 0) al_l[r32] = (a_); LDS_WAIT(); \
        _Pragma("unroll") for (int r_ = 0; r_ < 16; ++r_) { const float av_ = al_l[crow(r_, hi)]; _Pragma("unroll") for (int d_ = 0; d_ < 4; ++d_) o[d_][r_] *= av_; } } } while (0)
    f32x16 pA0, pA1, pB0, pB1; float mnA, mnB, alA, alB; bf16x8 pa0, pa1, pa2, pa3;
    SLOAD(0); VM_WAIT(); SWRITE(0); __syncthreads();
    m_qkt(pA0, pA1, lds + L_K, lds + L_R, QV(0), qr, r32, hi); m_partialSM(pA0, pA1, m_reg, mnA, alA);
    SLOAD(1); VM_WAIT(); SWRITE(1); __syncthreads();
    for (int j = 1; j + 1 < NT; j += 2) {
        SBAR(); m_qkt(pB0, pB1, lds + L_K + 16384, lds + L_R + 8192, QV(j), qr, r32, hi);
        m_finishSM(pA0, pA1, alA, l_reg, pa0, pa1, pa2, pa3); SBAR();
        SLOAD(j + 1); SBAR();
        m_pv(o, vb0, pa0, pa1, pa2, pa3); m_partialSM(pB0, pB1, m_reg, mnB, alB);
        __syncthreads(); VM_WAIT(); SWRITE(0);
        RESC(alB); __syncthreads();
        SBAR(); m_qkt(pA0, pA1, lds + L_K, lds + L_R, QV(j + 1), qr, r32, hi);
        m_finishSM(pB0, pB1, alB, l_reg, pa0, pa1, pa2, pa3); SBAR();
        SLOAD(j + 2); SBAR();
        m_pv(o, vb0 + 16384, pa0, pa1, pa2, pa3); m_partialSM(pA0, pA1, m_reg, mnA, alA);
        __syncthreads(); VM_WAIT(); SWRITE(1);
        RESC(alA); __syncthreads();
    }
    SBAR(); m_qkt(pB0, pB1, lds + L_K + 16384, lds + L_R + 8192, QV(NT - 1), qr, r32, hi);
    m_finishSM(pA0, pA1, alA, l_reg, pa0, pa1, pa2, pa3); SBAR();
    m_pv(o, vb0, pa0, pa1, pa2, pa3); m_partialSM(pB0, pB1, m_reg, mnB, alB);
    __syncthreads(); RESC(alB);
    m_finishSM(pB0, pB1, alB, l_reg, pa0, pa1, pa2, pa3); SBAR();
    m_pv(o, vb0 + 16384, pa0, pa1, pa2, pa3);
#undef SLOAD
#undef SWRITE
#undef QV
#undef RESC
    if (hi == 0) li_l[r32] = l_reg;
    LDS_WAIT();
    bf16* Ow = U.O + (size_t)(wid * 32) * U.ldo;
#pragma unroll
    for (int r = 0; r < 16; ++r) { const int orow = crow(r, hi); const float rl = 1.f / li_l[orow];
#pragma unroll
        for (int d0 = 0; d0 < 4; ++d0) Ow[(size_t)orow * U.ldo + d0 * 32 + r32] = (bf16)f2bf(o[d0][r] * rl); }
    __syncthreads();
}
#undef KSWZ
#undef RSWZ
#undef SBAR
}
constexpr int NPHASE = 20;
#ifndef PROBE_REP0
#define PROBE_REP0 1
#endif
#ifndef PROBE_REP4
#define PROBE_REP4 1
#endif
#ifndef PROBE_REP7
#define PROBE_REP7 1
#endif
#ifndef PROBE_REP14
#define PROBE_REP14 1
#endif
__device__ __forceinline__ unsigned queue_next(LAS unsigned char* lds, gu32* ctr, int home, unsigned n_per, int tid) {
    LAS unsigned* qw = (LAS unsigned*)(lds + LDSCTL_OFF + 64);
    __syncthreads();
    if (tid == 0) { unsigned r = 0xffffffffu;
        for (int k = 0; k < 8; ++k) { const int x = (home + k) & 7; const unsigned i = __hip_atomic_fetch_add(ctr + 64 * x, 1u, RLX_AGENT); if (i < n_per) { r = (unsigned)x * n_per + i; break; } }
        *qw = r; }
    __syncthreads();
    return (unsigned)__builtin_amdgcn_readfirstlane((int)*qw);
}

__device__ __forceinline__ void phase_even_hgrn(const Args& args, LAS unsigned char* lds, int tid, int vcu, int G, unsigned long long& wacc) {
        { const bool fast = G >= 256; int it = vcu; const int step = fast ? (vcu < 128 ? 4096 : G - 128) : G;
          for (; it < 640; it += step) hg::hgrn_item(lds, args, it < 128 ? 1 : 0, it < 128 ? it : it - 128, tid, wacc); }
}

__device__ __forceinline__ void phase_even_attn(const Args& args, LAS unsigned char* lds, gu32* qctr, int home, int tid) {
    unsigned char* ws = args.ws; bf16* Bbuf = (bf16*)(ws + WS_B); bf16* Cbuf = (bf16*)(ws + WS_C);
        const bf16* nak = (const bf16*)(args.out + O_CKV); const bf16* nav = (const bf16*)(args.out + O_CKV + 2097152); const float* bt = (const float*)(ws + WS_BIAS);
        for (;;) {
            const unsigned uq = queue_next(lds, qctr, home, 96u, tid);
            if (uq == 0xffffffffu) break;
            const unsigned lx = uq / 96u, li = uq % 96u;
            const unsigned u = li < 64u ? ((lx + 8u * (li >> 3)) << 3) + (li & 7u) : 512u + lx + 8u * (li - 64u);
            att::Unit U; U.ldq = 4096; U.ldo = 2048; U.rope = nullptr; U.pos0 = 0; U.C = 0.08838834764831845f * LOG2E;
            const bf16* P2 = (const bf16*)(ws + WS_P2);
            if (u < 512u) { const int b = u >> 6, h = (u >> 3) & 7, qb = u & 7; const size_t row0 = (size_t)MC + b * LT + qb * 256;
                const int r0 = 4 * qb; int rs = r0 - 4; rs = rs < 0 ? 0 : (rs > 24 ? 24 : rs); int re = r0 - 1; re = re < 0 ? 0 : (re > 24 ? 24 : re); re += 8;
                U.Q = P2 + row0 * 4096 + 1024 + h * 128; U.O = Bbuf + row0 * 2048 + 1024 + h * 128;
                const bf16* kb = P2 + ((size_t)MC + b * LT + rs * 64) * 4096 + 2048 + h * 128;
                U.s0 = att::Seg{kb, kb + 1024, nullptr, 4096, re - rs};
                U.s1 = att::Seg{nak + (size_t)b * 512 * 1024 + h * 128, nav + (size_t)b * 512 * 1024 + h * 128, nullptr, 1024, 8};
                U.bias = bt + (size_t)h * 16 * 4096; U.r0 = r0; U.rs = rs;
                att::attn_unit<128, true>(lds, U, tid); }
            else { const int i = u - 512, b = i >> 3, h = i & 7; const size_t row0 = (size_t)b * CT;
                U.Q = P2 + row0 * 4096 + 1024 + h * 128; U.O = Bbuf + row0 * 2048 + 1024 + h * 128;
                const bf16* kb = P2 + row0 * 4096 + 2048 + h * 128;
                U.s0 = att::Seg{kb, kb + 1024, nullptr, 4096, 4}; U.s1 = att::Seg{kb, kb + 1024, nullptr, 4096, 0}; U.bias = nullptr; U.r0 = 0; U.rs = 0;
                att::attn_unit<128, false>(lds, U, tid); }
        }
}

__device__ __forceinline__ void phase_mla_attn(const Args& args, LAS unsigned char* lds, gu32* qctr, int home, int tid) {
    unsigned char* ws = args.ws; bf16* Bbuf = (bf16*)(ws + WS_B); bf16* Cbuf = (bf16*)(ws + WS_C);

        const bf16* qb_ = Cbuf; const bf16* kv = (const bf16*)(ws + WS_CKVX); const bf16* krot = (const bf16*)(ws + WS_D_KROT); const float* rope = (const float*)(ws + WS_ROPE);
        for (;;) {
            const unsigned uq = queue_next(lds, qctr, home, 192u, tid);
            if (uq == 0xffffffffu) break;
            const unsigned lx = uq / 192u, li = uq % 192u;
            const unsigned u = li < 128u ? ((lx + 8u * (li >> 3)) << 3) + (li & 7u) : 1024u + lx + 8u * (li - 128u);
            att::Unit U; U.ldq = 3072; U.ldo = 2048; U.bias = nullptr; U.r0 = 0; U.rs = 0; U.C = 0.07216878364870322f * LOG2E;
            if (u < 1024u) { const int b = u >> 7, h = (u >> 3) & 15, qb = u & 7; const size_t row0 = (size_t)MC + b * LT + qb * 256;
                U.Q = qb_ + row0 * 3072 + h * 192; U.O = Bbuf + row0 * 2048 + h * 128; U.rope = rope; U.pos0 = qb * 256;
                const bf16* kb = kv + ((size_t)MC + b * LT) * 4096 + h * 256; const bf16* kc = kv + ((size_t)MT + b * PAST) * 4096 + h * 256;
                U.s0 = att::Seg{kb, kb + 128, krot + ((size_t)MC + b * LT) * 64, 4096, 32}; U.s1 = att::Seg{kc, kc + 128, krot + ((size_t)MT + b * PAST) * 64, 4096, 8}; }
            else { const int i = u - 1024, b = i >> 4, h = i & 15; const size_t row0 = (size_t)b * CT;
                U.Q = qb_ + row0 * 3072 + h * 192; U.O = Bbuf + row0 * 2048 + h * 128; U.rope = nullptr; U.pos0 = 0;
                const bf16* kb = kv + row0 * 4096 + h * 256;
                U.s0 = att::Seg{kb, kb + 128, krot + row0 * 64, 4096, 4}; U.s1 = att::Seg{kb, kb + 128, krot + row0 * 64, 4096, 0}; }
            att::attn_mla_unit(lds, U, tid);
        }
}

__global__ void __launch_bounds__(512, 2) mega_fwd(Args args) {
    extern __shared__ __attribute__((aligned(16))) unsigned char lds_raw[];
    LAS unsigned char* lds = (LAS unsigned char*)lds_raw;
    const int tid = threadIdx.x, lane = tid & 63, wave = __builtin_amdgcn_readfirstlane(tid >> 6);
    const int G = gridDim.x; const int bx = blockIdx.x; const int vcu = (G % 8 == 0) ? (bx % 8) * (G / 8) + bx / 8 : bx;
    const int gw = vcu * 8 + wave, NGW = G * 8;
    const int home = (G % 8 == 0) ? (vcu / (G / 8)) & 7 : 0;
    unsigned char* ws = args.ws;
    gu32* ctl = (gu32*)(ws + WS_CTL);
    for (int u = tid; u < (LDS_BYTES - LDSCTL_OFF) / 4; u += 512) ((LAS unsigned*)(lds + LDSCTL_OFF))[u] = 0u;
    __syncthreads();
    volatile LAS unsigned* MISC = (volatile LAS unsigned*)(lds + MISC_OFF);
    XcdBarrier bar = xcd_barrier_post((unsigned*)(ws + WS_CTL) + CW_BAR + args.li * XCD_BAR_WORDS, MISC + 8);
    const int lo = args.ph_lo, hi = args.ph_hi;
    unsigned long long hg_wacc = 0ull;
#define IN(k) (lo <= (k) && (k) < hi)
#ifdef PROBE_MASK
    unsigned long long pt_prev = __builtin_amdgcn_s_memrealtime(), pt_acc = 0ull;
#define SEAM(k) do { if (IN(k) && IN((k) + 1)) xcd_barrier(bar); { const unsigned long long t_ = __builtin_amdgcn_s_memrealtime(); if ((PROBE_MASK >> (k)) & 1u) pt_acc += t_ - pt_prev; pt_prev = t_; } } while (0)
#else
#define SEAM(k) do { if (IN(k) && IN((k) + 1)) xcd_barrier(bar); } while (0)
#endif
    bf16* Bbuf = (bf16*)(ws + WS_B); bf16* Cbuf = (bf16*)(ws + WS_C); bf16* Dbuf = (bf16*)(ws + WS_D);
    const float* mod = (const float*)(ws + WS_MOD);
    const float* ng = args.in[I_NG];

    if (IN(0)) { phase_prologue(args, lds, tid, lane, wave, vcu, G);
#if PROBE_REP0 == 2
        xcd_barrier(bar); phase_prologue(args, lds, tid, lane, wave, vcu, G);
#endif
    }
    SEAM(0);
    if (IN(1)) phase_mod_reduce(args, gw, lane, NGW);
    SEAM(1);
    if (IN(2)) row_pass<false, true>(args.in[I_XP], args.in[I_XS], nullptr, nullptr, Bbuf, nullptr, nullptr, ng, mod, mod + 2048, gw, lane, NGW);
    SEAM(2);
    if (IN(3)) { pg8::Gemm g{Bbuf, (const bf16*)(ws + WS_WINE), MT, EVEN_IN, DM}; pg8::StaticOrder S; S.init(MT, EVEN_IN, G, bx);
        pg8::EpiT<3> E{Cbuf, EVEN_IN, nullptr, 0, args.out + O_NK, args.out + O_NV, (bf16*)(ws + WS_P2), (const float*)(ws + WS_LBT)};
        pg8::gemm_phase<pg8::EpiT<3>, pg8::StaticOrder, true, true>(lds, g, S, E); }
    SEAM(3);
    if (IN(4)) { phase_even_hgrn(args, lds, tid, vcu, G, hg_wacc);
#if PROBE_REP4 == 2
        xcd_barrier(bar); phase_even_hgrn(args, lds, tid, vcu, G, hg_wacc); xcd_barrier(bar);
#endif
        { LAS float* scr = (LAS float*)(lds + wave * 16384); LAS unsigned* qw = (LAS unsigned*)(lds + LDSCTL_OFF + 64);
          for (;;) { __syncthreads(); if (tid == 0) *qw = __hip_atomic_fetch_add(ctl + CW_Q2, 1u, RLX_AGENT); __syncthreads();
              const int pop = __builtin_amdgcn_readfirstlane((int)*qw); if (pop * 8 >= TRL_ITEMS) break;
              const int it = pop * 8 + wave; if (it < TRL_ITEMS) tr_late_item(args, scr, it, lane); } }
        phase_even_attn(args, lds, ctl + CW_Q0, home, tid);
#if PROBE_REP4 == 3
        xcd_barrier(bar); phase_even_attn(args, lds, ctl + CW_Q0 + 512, home, tid);
#endif
#if PROBE_REP4 == 4
        xcd_barrier(bar); phase_even_hgrn(args, lds, tid, vcu, G, hg_wacc); phase_even_attn(args, lds, ctl + CW_Q0 + 512, home, tid);
#endif
    }
    SEAM(4);
    if (IN(5)) phase_hgrn_combine(args, gw, lane, NGW);
    SEAM(5);
    if (IN(6)) { pg8::Gemm g{Bbuf, (const bf16*)(ws + WS_WOUTE), MT, DM, DM}; pg8::StaticOrder S; S.init(MT, DM, G, bx); pg8::EpiT<0> E{Dbuf, DM, nullptr, 0, nullptr, nullptr, nullptr, nullptr};
        pg8::gemm_phase<pg8::EpiT<0>, pg8::StaticOrder, true, true>(lds, g, S, E); }
    SEAM(6);
    if (IN(7)) { row_pass<true, true>(args.in[I_XP], args.in[I_XS], Dbuf, args.out, Bbuf, ng + 2048, mod + 2 * 2048, ng + 2 * 2048, mod + 3 * 2048, mod + 4 * 2048, gw, lane, NGW);
#if PROBE_REP7 == 2
        xcd_barrier(bar); row_pass<true, true>(args.in[I_XP], args.in[I_XS], Dbuf, args.out, Bbuf, ng + 2048, mod + 2 * 2048, ng + 2 * 2048, mod + 3 * 2048, mod + 4 * 2048, gw, lane, NGW);
#endif
    }
    SEAM(7);
    if (IN(8)) { pg8::Gemm g{Bbuf, (const bf16*)(ws + WS_W1_0), MT, DFF, DM}; pg8::StaticOrder S; S.init(MT, DFF, G, bx); pg8::EpiT<1> E{Cbuf, DFF, nullptr, 0, nullptr, nullptr, nullptr, nullptr};
        pg8::gemm_phase<pg8::EpiT<1>, pg8::StaticOrder, true, true>(lds, g, S, E); }
    SEAM(8);
    if (IN(9)) { pg8::Gemm g{Cbuf, (const bf16*)(ws + WS_W2_0), MT, DM, DFF}; pg8::StaticOrder S; S.init(MT, DM, G, bx); pg8::EpiT<0> E{Dbuf, DM, nullptr, 0, nullptr, nullptr, nullptr, nullptr};
        pg8::gemm_phase<pg8::EpiT<0>, pg8::StaticOrder, true, true>(lds, g, S, E); }
    SEAM(9);
    if (IN(10)) row_pass<true, true>(args.out, args.out + (size_t)MC * DM, Dbuf, args.out, Bbuf, ng + 3 * 2048, mod + 5 * 2048, ng + 4 * 2048, mod + 110592, mod + 110592 + 2048, gw, lane, NGW);
    SEAM(10);
    if (IN(11)) { pg8::Gemm g{Bbuf, (const bf16*)(ws + WS_WINO), MT, ODD_PAD, DM}; pg8::StaticOrder S; S.init(MT, ODD_PAD, G, bx); pg8::EpiT<2> E{nullptr, 0, (float*)(ws + WS_C), ODD_PAD, nullptr, nullptr, nullptr, nullptr};
        pg8::gemm_phase<pg8::EpiT<2>, pg8::StaticOrder, true, true>(lds, g, S, E); }
    SEAM(11);
    if (IN(12)) phase_mla_rows(args, gw, lane, NGW);
    SEAM(12);
    if (IN(13)) {
        { pg8::Gemm g{(const bf16*)(ws + WS_D_CQN), (const bf16*)(ws + WS_WUQ), MT, 3072, 512}; pg8::StaticOrder S; S.init(MT, 3072, G, bx); pg8::EpiT<0> E{Cbuf, 3072, nullptr, 0, nullptr, nullptr, nullptr, nullptr};
          pg8::gemm_phase<pg8::EpiT<0>, pg8::StaticOrder, true, true>(lds, g, S, E); }
        { pg8::Gemm g{(const bf16*)(ws + WS_D_CKVN), (const bf16*)(ws + WS_WUKV), MKV, 4096, 512}; pg8::StaticOrder S; S.init(MKV, 4096, G, bx); pg8::EpiT<0> E{(bf16*)(ws + WS_CKVX), 4096, nullptr, 0, nullptr, nullptr, nullptr, nullptr};
          pg8::gemm_phase<pg8::EpiT<0>, pg8::StaticOrder, true, true>(lds, g, S, E); }
    }
    SEAM(13);
    if (IN(14)) { phase_mla_attn(args, lds, ctl + CW_Q1, home, tid);
#if PROBE_REP14 == 2
        xcd_barrier(bar); phase_mla_attn(args, lds, ctl + CW_Q1 + 512, home, tid);
#endif
    }
    SEAM(14);
    if (IN(15)) { pg8::Gemm g{Bbuf, (const bf16*)(ws + WS_WOUTO), MT, DM, DM}; pg8::StaticOrder S; S.init(MT, DM, G, bx); pg8::EpiT<0> E{Dbuf, DM, nullptr, 0, nullptr, nullptr, nullptr, nullptr};
        pg8::gemm_phase<pg8::EpiT<0>, pg8::StaticOrder, true, true>(lds, g, S, E); }
    SEAM(15);
    { const float* mod1 = mod + 110592; const float* ng1 = ng + 4 * 2048;
    if (IN(16)) row_pass<true, true>(args.out, args.out + (size_t)MC * DM, Dbuf, args.out, Bbuf, ng1 + 2048, mod1 + 2 * 2048, ng1 + 2 * 2048, mod1 + 3 * 2048, mod1 + 4 * 2048, gw, lane, NGW);
    SEAM(16);
    if (IN(17)) { pg8::Gemm g{Bbuf, (const bf16*)(ws + WS_W1_1), MT, DFF, DM}; pg8::StaticOrder S; S.init(MT, DFF, G, bx); pg8::EpiT<1> E{Cbuf, DFF, nullptr, 0, nullptr, nullptr, nullptr, nullptr};
        pg8::gemm_phase<pg8::EpiT<1>, pg8::StaticOrder, true, true>(lds, g, S, E); }
    SEAM(17);
    if (IN(18)) { pg8::Gemm g{Cbuf, (const bf16*)(ws + WS_W2_1), MT, DM, DFF}; pg8::StaticOrder S; S.init(MT, DM, G, bx); pg8::EpiT<0> E{Dbuf, DM, nullptr, 0, nullptr, nullptr, nullptr, nullptr};
        pg8::gemm_phase<pg8::EpiT<0>, pg8::StaticOrder, true, true>(lds, g, S, E); }
    SEAM(18);
    if (IN(19)) row_pass<true, false>(args.out, args.out + (size_t)MC * DM, Dbuf, args.out, nullptr, ng1 + 3 * 2048, mod1 + 5 * 2048, nullptr, nullptr, nullptr, gw, lane, NGW);
    }
#ifdef PROBE_HGWAIT
    { hg_wacc = (unsigned long long)__builtin_amdgcn_readfirstlane((int)hg_wacc); const unsigned long long t0_ = __builtin_amdgcn_s_memrealtime(); while (__builtin_amdgcn_s_memrealtime() - t0_ < 4ull * hg_wacc) __builtin_amdgcn_s_sleep(8); }
#endif
#ifdef PROBE_MASK
    { const unsigned long long t_ = __builtin_amdgcn_s_memrealtime(); if ((PROBE_MASK >> 19) & 1u) pt_acc += t_ - pt_prev;
      const unsigned long long t0_ = __builtin_amdgcn_s_memrealtime(); while (__builtin_amdgcn_s_memrealtime() - t0_ < (unsigned long long)PROBE_AMP * pt_acc) __builtin_amdgcn_s_sleep(8); }
#endif
#undef IN
#undef SEAM
}

#ifndef MK_SPLITS
#define MK_SPLITS 1
#endif
extern "C" void kernel_launch(void* const* d_in, const int* in_sizes, int n_in, void* d_out, int out_size, void* d_ws, size_t ws_size, hipStream_t stream) {
    static int grid = 0;
    if (grid == 0) {
        if (n_in != 27 || (size_t)out_size != O_END || ws_size < WS_END) { fprintf(stderr, "kernel_launch: shape mismatch n_in %d out %d ws %zu (need %zu)\n", n_in, out_size, ws_size, (size_t)WS_END); grid = -1; return; }
        int dev = 0, cus = 0, per_cu = 0;
        if (hipGetDevice(&dev) != hipSuccess || hipDeviceGetAttribute(&cus, hipDeviceAttributeMultiprocessorCount, dev) != hipSuccess) { grid = -1; return; }
        if (hipFuncSetAttribute((const void*)mega_fwd, hipFuncAttributeMaxDynamicSharedMemorySize, LDS_BYTES) != hipSuccess) { fprintf(stderr, "kernel_launch: hipFuncSetAttribute failed\n"); grid = -1; return; }
        if (hipOccupancyMaxActiveBlocksPerMultiprocessor(&per_cu, (const void*)mega_fwd, 512, LDS_BYTES) != hipSuccess || per_cu < 1) { fprintf(stderr, "kernel_launch: occupancy query says %d\n", per_cu); }
        (void)hipGetLastError();
        grid = cus;
    }
    if (grid < 0) return;
    (void)hipMemsetAsync((char*)d_ws + WS_CTL, 0, CTL_ZERO_BYTES, stream);
    Args a{};
    for (int i = 0; i < 27; ++i) a.in[i] = (const float*)d_in[i];
    a.out = (float*)d_out; a.ws = (unsigned char*)d_ws; a.pad = 0;
#if MK_SPLITS == 1
    a.ph_lo = 0; a.ph_hi = NPHASE; a.li = 0;
    hipLaunchKernelGGL(mega_fwd, dim3(grid), dim3(512), LDS_BYTES, stream, a);
#else
    for (int k = 0; k < NPHASE; ++k) { a.ph_lo = k; a.ph_hi = k + 1; a.li = 0; hipLaunchKernelGGL(mega_fwd, dim3(grid), dim3(512), LDS_BYTES, stream, a); }
#endif
}
```
